# Optimizing an MI355X kernel written in HIP

```python
import math
import jax, jax.numpy as jnp
from jax import lax
import numpy as np

D_MODEL = 2048
BATCH = 32
SEQ = 256
DEPTH = 1
DEC_BATCH = 8
DEC_SEQ = 1024
PAST_LEN = 512

GRID_W = 64
D_MIX = D_MODEL
D_CHUNK = D_MIX // 2
D_SSM = D_MIX - D_CHUNK
CHUNK = 128
CHUNK_HEADS = 8
CHUNK_HEAD_DIM = D_CHUNK // CHUNK_HEADS
SSM_GROUP = 16
N_SSM_GROUPS = D_SSM // SSM_GROUP
SSM_STATE = 64
D_IN = 2 * D_CHUNK + D_SSM
D_FF = 4 * D_MODEL
N_MOD = 6
EPS = 1e-6
DT_MIN = 1e-3
DT_MAX = 1e-1

kernel_name = "hybrid_chunkmlp_s5_prefix_diffusion_step"


def rmsnorm(x, g):
    xf = x.astype(jnp.float32)
    y = xf * lax.rsqrt(jnp.mean(xf * xf, axis=-1, keepdims=True) + EPS)
    return (y * g.astype(jnp.float32)).astype(x.dtype)


def grid_pos_embed(n_tok, dtype):
    rows = n_tok // GRID_W
    quarter = D_MODEL // 4
    freqs = 1.0 / (10000.0 ** (jnp.arange(quarter, dtype=jnp.float32) / quarter))
    r_ang = jnp.arange(rows, dtype=jnp.float32)[:, None] * freqs[None, :]
    c_ang = jnp.arange(GRID_W, dtype=jnp.float32)[:, None] * freqs[None, :]
    r_emb = jnp.concatenate([jnp.sin(r_ang), jnp.cos(r_ang)], axis=-1)
    c_emb = jnp.concatenate([jnp.sin(c_ang), jnp.cos(c_ang)], axis=-1)
    pos = jnp.concatenate([
        jnp.broadcast_to(r_emb[:, None, :], (rows, GRID_W, D_MODEL // 2)),
        jnp.broadcast_to(c_emb[None, :, :], (rows, GRID_W, D_MODEL // 2))], axis=-1)
    return pos.reshape(rows * GRID_W, D_MODEL).astype(dtype)


def modulation(cvec, w_ada, b_ada):
    return jax.nn.silu(cvec) @ w_ada + b_ada


def chunk_mlp_mixer(u, v, w_s, b_s, g_v):
    bsz, seq_len, _ = u.shape
    n_chunks = seq_len // CHUNK
    vh = rmsnorm(v, g_v).reshape(bsz, n_chunks, CHUNK, CHUNK_HEADS, CHUNK_HEAD_DIM)
    z = jnp.einsum("hpq,bnqhd->bnphd", w_s, vh) + b_s.T[None, None, :, :, None]
    return u * z.reshape(bsz, seq_len, D_CHUNK)


def ssm_discretize(lam_re, lam_im, log_dt, b_re, b_im):
    lam = lax.complex(lam_re.astype(jnp.float32), lam_im.astype(jnp.float32))
    dt = jnp.exp(log_dt.astype(jnp.float32))[:, None]
    lam_bar = jnp.exp(lam * dt)
    b = lax.complex(b_re.astype(jnp.float32), b_im.astype(jnp.float32))
    b_bar = ((lam_bar - 1.0) / lam)[..., None] * b
    return lam_bar, b_bar


def _scan_combine(e1, e2):
    a1, b1 = e1
    a2, b2 = e2
    return a1 * a2, a2 * b1 + b2


def ssm_scan(u, lam_bar, b_bar, h0, reverse):
    bu = jnp.einsum("gph,blgh->blgp", b_bar, u)
    first = -1 if reverse else 0
    bu = bu.at[:, first].add(lam_bar * h0)
    a = jnp.broadcast_to(lam_bar, bu.shape)
    _, h = lax.associative_scan(_scan_combine, (a, bu), axis=1, reverse=reverse)
    return h


def s5_mixer(x, lam_re, lam_im, log_dt, b_re, b_im, c_re, c_im, d_skip, w_glu, b_glu, h0_f, h0_b):
    bsz, seq_len, _ = x.shape
    xf = x.astype(jnp.float32)
    u = xf.reshape(bsz, seq_len, N_SSM_GROUPS, SSM_GROUP).astype(jnp.complex64)
    lam_f, bb_f = ssm_discretize(lam_re[0], lam_im[0], log_dt[0], b_re[0], b_im[0])
    lam_b, bb_b = ssm_discretize(lam_re[1], lam_im[1], log_dt[1], b_re[1], b_im[1])
    h_f = ssm_scan(u, lam_f, bb_f, h0_f, False)
    h_b = ssm_scan(u, lam_b, bb_b, h0_b, True)
    c_f = lax.complex(c_re[0].astype(jnp.float32), c_im[0].astype(jnp.float32))
    c_b = lax.complex(c_re[1].astype(jnp.float32), c_im[1].astype(jnp.float32))
    y = (jnp.einsum("ghp,blgp->blgh", c_f, h_f) + jnp.einsum("ghp,blgp->blgh", c_b, h_b)).real
    y = y.reshape(bsz, seq_len, D_SSM) + d_skip.astype(jnp.float32) * xf
    y = jax.nn.gelu(y)
    y = y * jax.nn.sigmoid(y @ w_glu.astype(jnp.float32) + b_glu.astype(jnp.float32))
    return y.astype(x.dtype), h_f[:, -1], h_b[:, 0]


def trunk_layer(x, mod, h0_f, h0_b, p):
    shift_m, scale_m, gate_m, shift_f, scale_f, gate_f = jnp.split(mod, N_MOD, axis=-1)
    h = rmsnorm(x, p["g_pre_mix"]) * (1.0 + scale_m) + shift_m
    proj = h @ p["w_in"]
    u_a, v_a, u_b = jnp.split(proj, [D_CHUNK, 2 * D_CHUNK], axis=-1)
    y_a = chunk_mlp_mixer(u_a, v_a, p["chunk_w_s"], p["chunk_b_s"], p["chunk_g_v"])
    y_b, hf, hb = s5_mixer(u_b, p["ssm_lam_re"], p["ssm_lam_im"], p["ssm_log_dt"],
                           p["ssm_b_re"], p["ssm_b_im"], p["ssm_c_re"], p["ssm_c_im"],
                           p["ssm_d"], p["w_glu"], p["b_glu"], h0_f, h0_b)
    mix = jnp.concatenate([rmsnorm(y_a, p["g_out_a"]), rmsnorm(y_b, p["g_out_b"])], axis=-1) @ p["w_out"]
    x = x + gate_m * rmsnorm(mix, p["g_post_mix"])
    h = rmsnorm(x, p["g_pre_ffn"]) * (1.0 + scale_f) + shift_f
    f = jnp.square(jax.nn.relu(h @ p["w_ff1"])) @ p["w_ff2"]
    x = x + gate_f * rmsnorm(f, p["g_post_ffn"])
    return x, hf, hb


def setup_inputs(seed: int = 0) -> dict:
    key = jax.random.key(seed)
    ks = jax.random.split(key, 32)
    f32 = jnp.float32
    nrm = lambda k, shape, s: jax.random.normal(k, shape, f32) * s
    gain = lambda k, shape: 1.0 + 0.02 * jax.random.normal(k, shape, f32)
    lam_im_base = math.pi * jnp.arange(SSM_STATE, dtype=f32)
    return {
        "x_prompt": nrm(ks[0], (BATCH, SEQ, D_MODEL), 1.0),
        "x_sample": nrm(ks[1], (DEC_BATCH, DEC_SEQ, D_MODEL), 1.0),
        "state_ssm": nrm(ks[2], (DEC_BATCH, DEPTH, 2, 2, N_SSM_GROUPS, SSM_STATE), 0.3),
        "c": nrm(ks[3], (DEC_BATCH, D_MODEL), 1.0),
        "c_ctx": nrm(ks[4], (D_MODEL,), 1.0),
        "w_ada": nrm(ks[5], (DEPTH, D_MODEL, N_MOD * D_MODEL), 0.5 * D_MODEL ** -0.5),
        "b_ada": nrm(ks[6], (DEPTH, N_MOD * D_MODEL), 0.02),
        "g_pre_mix": gain(ks[7], (DEPTH, D_MODEL)),
        "w_in": nrm(ks[8], (DEPTH, D_MODEL, D_IN), D_MODEL ** -0.5),
        "chunk_w_s": nrm(ks[9], (DEPTH, CHUNK_HEADS, CHUNK, CHUNK), CHUNK ** -0.5),
        "chunk_b_s": gain(ks[10], (DEPTH, CHUNK_HEADS, CHUNK)),
        "chunk_g_v": gain(ks[11], (DEPTH, D_CHUNK)),
        "ssm_lam_re": -0.5 + 0.01 * jax.random.normal(ks[12], (DEPTH, 2, N_SSM_GROUPS, SSM_STATE), f32),
        "ssm_lam_im": lam_im_base + 0.01 * jax.random.normal(ks[13], (DEPTH, 2, N_SSM_GROUPS, SSM_STATE), f32),
        "ssm_log_dt": jax.random.uniform(ks[14], (DEPTH, 2, N_SSM_GROUPS), f32, math.log(DT_MIN), math.log(DT_MAX)),
        "ssm_b_re": nrm(ks[15], (DEPTH, 2, N_SSM_GROUPS, SSM_STATE, SSM_GROUP), (2 * SSM_GROUP) ** -0.5),
        "ssm_b_im": nrm(ks[16], (DEPTH, 2, N_SSM_GROUPS, SSM_STATE, SSM_GROUP), (2 * SSM_GROUP) ** -0.5),
        "ssm_c_re": nrm(ks[17], (DEPTH, 2, N_SSM_GROUPS, SSM_GROUP, SSM_STATE), 2.0 ** -0.5),
        "ssm_c_im": nrm(ks[18], (DEPTH, 2, N_SSM_GROUPS, SSM_GROUP, SSM_STATE), 2.0 ** -0.5),
        "ssm_d": nrm(ks[19], (DEPTH, D_SSM), 0.5),
        "w_glu": nrm(ks[20], (DEPTH, D_SSM, D_SSM), D_SSM ** -0.5),
        "b_glu": nrm(ks[21], (DEPTH, D_SSM), 0.02),
        "g_out_a": gain(ks[22], (DEPTH, D_CHUNK)),
        "g_out_b": gain(ks[23], (DEPTH, D_SSM)),
        "w_out": nrm(ks[24], (DEPTH, D_MIX, D_MODEL), D_MIX ** -0.5),
        "g_post_mix": gain(ks[25], (DEPTH, D_MODEL)),
        "g_pre_ffn": gain(ks[26], (DEPTH, D_MODEL)),
        "w_ff1": nrm(ks[27], (DEPTH, D_MODEL, D_FF), D_MODEL ** -0.5),
        "w_ff2": nrm(ks[28], (DEPTH, D_FF, D_MODEL), D_FF ** -0.5),
        "g_post_ffn": gain(ks[29], (DEPTH, D_MODEL)),
    }


def reference(x_prompt, x_sample, state_ssm, c, c_ctx, w_ada, b_ada, g_pre_mix, w_in,
              chunk_w_s, chunk_b_s, chunk_g_v, ssm_lam_re, ssm_lam_im, ssm_log_dt,
              ssm_b_re, ssm_b_im, ssm_c_re, ssm_c_im, ssm_d, w_glu, b_glu, g_out_a, g_out_b,
              w_out, g_post_mix, g_pre_ffn, w_ff1, w_ff2, g_post_ffn):
    def layer_params(l):
        return {
            "g_pre_mix": g_pre_mix[l], "w_in": w_in[l],
            "chunk_w_s": chunk_w_s[l], "chunk_b_s": chunk_b_s[l], "chunk_g_v": chunk_g_v[l],
            "ssm_lam_re": ssm_lam_re[l], "ssm_lam_im": ssm_lam_im[l], "ssm_log_dt": ssm_log_dt[l],
            "ssm_b_re": ssm_b_re[l], "ssm_b_im": ssm_b_im[l], "ssm_c_re": ssm_c_re[l], "ssm_c_im": ssm_c_im[l],
            "ssm_d": ssm_d[l], "w_glu": w_glu[l], "b_glu": b_glu[l],
            "g_out_a": g_out_a[l], "g_out_b": g_out_b[l], "w_out": w_out[l],
            "g_post_mix": g_post_mix[l], "g_pre_ffn": g_pre_ffn[l],
            "w_ff1": w_ff1[l], "w_ff2": w_ff2[l], "g_post_ffn": g_post_ffn[l],
        }

    n_ctx_req = x_prompt.shape[0]
    h_zero = jnp.zeros((n_ctx_req, N_SSM_GROUPS, SSM_STATE), jnp.complex64)
    x = x_prompt
    ctx_states = []
    for l in range(DEPTH):
        mod_ctx = modulation(c_ctx, w_ada[l], b_ada[l])[None, None, :]
        x, hf, hb = trunk_layer(x, mod_ctx, h_zero, h_zero, layer_params(l))
        st_f = jnp.stack([hf.real, hf.imag], axis=1)
        st_b = jnp.stack([hb.real, hb.imag], axis=1)
        ctx_states.append(jnp.stack([st_f, st_b], axis=1))
    y_prompt = x
    new_state_ssm = jnp.stack(ctx_states, axis=1)

    st = state_ssm.astype(jnp.float32)
    x = x_sample + grid_pos_embed(x_sample.shape[1], x_sample.dtype)
    for l in range(DEPTH):
        h0_f = lax.complex(st[:, l, 0, 0], st[:, l, 0, 1])
        h0_b = lax.complex(st[:, l, 1, 0], st[:, l, 1, 1])
        mod_lat = modulation(c, w_ada[l], b_ada[l])[:, None, :]
        x, _, _ = trunk_layer(x, mod_lat, h0_f, h0_b, layer_params(l))
    y_sample = x

    return (y_prompt, y_sample, new_state_ssm)
```

```cpp
#include <hip/hip_runtime.h>
#include <hip/hip_cooperative_groups.h>
#include <cstdio>
#include <cstdint>
namespace cg = cooperative_groups;

#ifndef MK_MULTI
#define MK_MULTI 0
#endif

#define LAS __attribute__((address_space(3)))
typedef unsigned short bf16_t;
typedef short bf16x8 __attribute__((ext_vector_type(8)));
typedef float f32x4 __attribute__((ext_vector_type(4)));
typedef float f32x2 __attribute__((ext_vector_type(2)));
typedef unsigned u32x4 __attribute__((ext_vector_type(4)));
typedef unsigned u32x2 __attribute__((ext_vector_type(2)));

typedef __bf16 bf16x2v __attribute__((ext_vector_type(2)));
__device__ __forceinline__ unsigned cvt_pk_bf16(float lo, float hi) { const f32x2 v = {lo, hi}; return __builtin_bit_cast(unsigned, __builtin_convertvector(v, bf16x2v)); }
__device__ __forceinline__ float bf_lo(unsigned w) { return __uint_as_float(w << 16); }
__device__ __forceinline__ float bf_hi(unsigned w) { return __uint_as_float(w & 0xffff0000u); }
#define LDS_WAIT() asm volatile("s_waitcnt lgkmcnt(0)" ::: "memory")
#define VM_WAIT() asm volatile("s_waitcnt vmcnt(0)" ::: "memory")
__device__ __forceinline__ float wave_sum(float v) {
#pragma unroll
    for (int o = 1; o < 64; o <<= 1) v += __shfl_xor(v, o);
    return v;
}

namespace pg8 {
constexpr int BM = 256, BK = 64, HALF = 128, HTB = HALF * BK * 2, STAGE_BYTES = 8 * HTB, NXCD = 8, WGM = 8;
__host__ __device__ __forceinline__ int lds_byte(int r, int c) { const int st = (r >> 4) * 2 + (c >> 5), rr = r & 15, cc = c & 31, ob = rr * 64 + cc * 2; return st * 1024 + (ob ^ (((ob >> 9) & 1) << 5)); }
__host__ __device__ __forceinline__ void stage_rc(int b, int& R, int& C) { const int st = b / 1024, sb = b % 1024, swz = sb ^ (((sb >> 9) & 1) << 5); R = (st >> 1) * 16 + swz / 64; C = (st & 1) * 32 + (swz % 64) / 2; }
__host__ __device__ __forceinline__ int perm32(int rho) { const int n = rho >> 4, i = rho & 15; return 8 * (i >> 2) + 4 * n + (i & 3); }

struct Unit { int pm, pn; };
struct Gemm { const bf16_t* A; const bf16_t* Bt; int M, N, K; };

struct StaticOrder {
    int nM, nN, nwg, G, c;
    __host__ __device__ void init(int M, int N, int G_, int c_) { nM = M / BM; nN = N / BM; nwg = nM * nN; G = G_; c = c_; }
    __host__ __device__ bool next(int i, Unit& u) const {
        const long L = (long)i * G + c; if (L >= nwg) return false;
        int wgid = (int)L; { const int q = nwg / NXCD, r = nwg % NXCD, xcd = wgid % NXCD, off = wgid / NXCD; wgid = (xcd < r ? xcd * (q + 1) : r * (q + 1) + (xcd - r) * q) + off; }
        const int nig = WGM * nN, gid = wgid / nig, fm = gid * WGM, gsz = (nM - fm) < WGM ? (nM - fm) : WGM;
        u.pm = fm + ((wgid % nig) % gsz); u.pn = (wgid % nig) / gsz; return true;
    }
    __device__ __forceinline__ void a_ready(const Unit&) const {}
    __device__ __forceinline__ void done(const Unit&) const {}
};

template <int MODE> struct EpiB {
    static constexpr bool PERM = true, AFTER_DRAIN = false;
    bf16_t* O; int ldc; const float* bias; const bf16_t* Y; int yld; const float* gain; float* sq;
    __device__ __forceinline__ void operator()(const f32x4 (&acc)[2][2][4][2], const Unit& u, int wr, int wc, int fr, int fq) const {
        const int row0 = u.pm * BM + wr * 64 + fr; const int col0 = u.pn * BM + wc * 32 + 8 * fq;
        f32x4 bv[2][2], gv[2][2];
#pragma unroll
        for (int bj = 0; bj < 2; ++bj)
#pragma unroll
            for (int n = 0; n < 2; ++n) { bv[bj][n] = (MODE == 2) ? *(const f32x4*)(bias + col0 + bj * HALF + 4 * n) : (f32x4){0.f, 0.f, 0.f, 0.f};
                gv[bj][n] = (MODE == 2) ? *(const f32x4*)(gain + col0 + bj * HALF + 4 * n) : (f32x4){1.f, 1.f, 1.f, 1.f}; }
#pragma unroll
        for (int ai = 0; ai < 2; ++ai)
#pragma unroll
            for (int m = 0; m < 4; ++m) { const int grow = row0 + ai * HALF + m * 16; const size_t ro = (size_t)grow * ldc + col0; float rsq = 0.f;
                const float rsc = (MODE == 3) ? sq[grow] : 1.f;
#pragma unroll
                for (int bj = 0; bj < 2; ++bj) { f32x4 v0 = acc[ai][bj][m][0], v1 = acc[ai][bj][m][1];
                    if (MODE == 1) {
#pragma unroll
                        for (int e = 0; e < 4; ++e) { float a = fmaxf(v0[e], 0.f), b = fmaxf(v1[e], 0.f); v0[e] = a * a; v1[e] = b * b; }
                    }
                    if (MODE == 2) { v0 += bv[bj][0]; v1 += bv[bj][1];
                        const u32x4 yw = *(const u32x4*)(Y + (size_t)grow * yld + col0 + bj * HALF);
                        float y[8] = {bf_lo(yw.x), bf_hi(yw.x), bf_lo(yw.y), bf_hi(yw.y), bf_lo(yw.z), bf_hi(yw.z), bf_lo(yw.w), bf_hi(yw.w)};
#pragma unroll
                        for (int e = 0; e < 4; ++e) { v0[e] = y[e] * __builtin_amdgcn_rcpf(1.f + __expf(-v0[e])); v1[e] = y[4 + e] * __builtin_amdgcn_rcpf(1.f + __expf(-v1[e])); }
                    }
                    if (MODE == 2 || MODE == 4) rsq += (v0[0] * v0[0] + v0[1] * v0[1]) + (v0[2] * v0[2] + v0[3] * v0[3]) + (v1[0] * v1[0] + v1[1] * v1[1]) + (v1[2] * v1[2] + v1[3] * v1[3]);
                    if (MODE == 2) { v0 *= gv[bj][0]; v1 *= gv[bj][1]; }
                    if (MODE == 3) { v0 *= rsc; v1 *= rsc; }
                    u32x4 w; w.x = cvt_pk_bf16(v0[0], v0[1]); w.y = cvt_pk_bf16(v0[2], v0[3]); w.z = cvt_pk_bf16(v1[0], v1[1]); w.w = cvt_pk_bf16(v1[2], v1[3]);
                    *(u32x4*)(O + ro + bj * HALF) = w; }
                if (MODE == 2 || (MODE == 4 && (u.pn >> 2) == 1)) { rsq += __shfl_xor(rsq, 16); rsq += __shfl_xor(rsq, 32); if (fq == 0) atomicAdd(sq + grow, rsq); } }
    }
};

template <class Epi, class Sched, bool ALIGN_EPI = false, bool SP2 = false, bool MID = false>
__device__ __forceinline__ void gemm_phase(LAS unsigned char* lds, const Gemm g, const Sched& S, const Epi& E, const float* sqa = nullptr, const float* sqb = nullptr) {
    const int tid = threadIdx.x, wid = __builtin_amdgcn_readfirstlane(tid >> 6), lane = tid & 63, wr = wid >> 2, wc = wid & 3, fr = lane & 15, fq = lane >> 4;
    const int K = g.K, nt = K / BK;
    unsigned voffA[2], voffB[2];
#pragma unroll
    for (int i = 0; i < 2; ++i) { int R, C; stage_rc(tid * 16 + i * 8192, R, C); const int Rb = Epi::PERM ? ((R & ~31) + perm32(R & 31)) : R;
        voffA[i] = (unsigned)(R * K + C) * 2u; voffB[i] = (unsigned)(Rb * K + C) * 2u; }
    const size_t kstep = (size_t)(BK * 2);
    const size_t hstep = (size_t)HALF * K * 2;
    const size_t tstep = 2 * hstep;
    const unsigned ldsw = (unsigned)wid * 1024u;
    const int aoff = lds_byte(wr * 64 + fr, fq * 8), boff = lds_byte(wc * 32 + fr, fq * 8);
#define PG8_SA(b, h) (((b) * 2 + (h)) * HTB)
#define PG8_SB(b, h) ((4 + (b) * 2 + (h)) * HTB)
#define PG8_STAGE(bufoff, gbase, voff) do { _Pragma("unroll") for (int _i = 0; _i < 2; ++_i) \
        __builtin_amdgcn_global_load_lds((const unsigned*)((const char*)(gbase) + (voff)[_i]), (LAS unsigned*)(lds + (bufoff) + ldsw + _i * 8192), 16, 0, 0); } while (0)
#define PG8_LDA(dst, b, h) do { _Pragma("unroll") for (int m = 0; m < 4; ++m) _Pragma("unroll") for (int k = 0; k < 2; ++k) dst[m][k] = *(const LAS bf16x8*)(lds + PG8_SA(b, h) + aoff + m * 2048 + k * 1024); } while (0)
#define PG8_LDB(dst, b, h) do { _Pragma("unroll") for (int n = 0; n < 2; ++n) _Pragma("unroll") for (int k = 0; k < 2; ++k) dst[n][k] = *(const LAS bf16x8*)(lds + PG8_SB(b, h) + boff + n * 2048 + k * 1024); } while (0)
#define PG8_MMA(ai, bj, At, Bt) do { __builtin_amdgcn_s_setprio(1); _Pragma("unroll") for (int m = 0; m < 4; ++m) _Pragma("unroll") for (int n = 0; n < 2; ++n) _Pragma("unroll") for (int k = 0; k < 2; ++k) \
        acc[ai][bj][m][n] = __builtin_amdgcn_mfma_f32_16x16x32_bf16(Bt[n][k], At[m][k], acc[ai][bj][m][n], 0, 0, 0); __builtin_amdgcn_s_setprio(0); } while (0)
#define PG8_WAIT_V(n) asm volatile("s_waitcnt vmcnt(" #n ")" ::: "memory")
#define PG8_WAIT_L(n) asm volatile("s_waitcnt lgkmcnt(" #n ")" ::: "memory")
#define PG8_BAR __builtin_amdgcn_s_barrier()
#define PG8_SCHED __builtin_amdgcn_sched_barrier(0)
    Unit cur, nxt; int ui = 0;
    if (!S.next(0, cur)) return;
    f32x4 acc[2][2][4][2];
#pragma unroll
    for (int a = 0; a < 2; ++a)
#pragma unroll
        for (int b = 0; b < 2; ++b)
#pragma unroll
            for (int m = 0; m < 4; ++m)
#pragma unroll
                for (int n = 0; n < 2; ++n) acc[a][b][m][n] = (f32x4){0.f, 0.f, 0.f, 0.f};
    bf16x8 At[4][2], B0[2][2], B1[2][2];
    const char* cA = (const char*)g.A + (size_t)cur.pm * tstep; const char* cB = (const char*)g.Bt + (size_t)cur.pn * tstep;
    S.a_ready(cur);
    if constexpr (SP2) {
        PG8_STAGE(PG8_SB(0, 0), cB, voffB); PG8_STAGE(PG8_SB(0, 1), cB + hstep, voffB); PG8_STAGE(PG8_SA(0, 0), cA, voffA); PG8_STAGE(PG8_SA(0, 1), cA + hstep, voffA);
        if (wr == 1) PG8_BAR;
        PG8_WAIT_V(2); PG8_BAR;
        PG8_STAGE(PG8_SB(1, 0), cB + kstep, voffB); PG8_STAGE(PG8_SA(1, 0), cA + kstep, voffA); PG8_STAGE(PG8_SB(1, 1), cB + hstep + kstep, voffB);
        PG8_WAIT_V(6); PG8_BAR;
    } else {
        PG8_STAGE(PG8_SB(0, 0), cB, voffB); PG8_STAGE(PG8_SA(0, 0), cA, voffA); PG8_STAGE(PG8_SB(0, 1), cB + hstep, voffB); PG8_STAGE(PG8_SA(0, 1), cA + hstep, voffA);
        if (wr == 1) PG8_BAR;
        PG8_WAIT_V(4); PG8_BAR;
        PG8_STAGE(PG8_SB(1, 0), cB + kstep, voffB); PG8_STAGE(PG8_SA(1, 0), cA + kstep, voffA); PG8_STAGE(PG8_SB(1, 1), cB + hstep + kstep, voffB);
        PG8_WAIT_V(6); PG8_BAR;
    }
    for (;;) {
        const bool has_next = S.next(ui + 1, nxt);
        const char* nA = has_next ? (const char*)g.A + (size_t)nxt.pm * tstep : cA; const char* nB = has_next ? (const char*)g.Bt + (size_t)nxt.pn * tstep : cB;
        for (int t = 0; t < nt; t += 2) {
            const bool last = (t == nt - 2);
            const char* a1 = cA + (size_t)(t + 1) * kstep;
            const char* a2 = last ? nA : cA + (size_t)(t + 2) * kstep; const char* b2 = last ? nB : cB + (size_t)(t + 2) * kstep;
            const char* a3 = a2 + kstep; const char* b3 = b2 + kstep;
            if (last && has_next) S.a_ready(nxt);
            if constexpr (MID) { if (t == (nt >> 1)) {
#pragma unroll
                for (int ai = 0; ai < 2; ++ai)
#pragma unroll
                    for (int m = 0; m < 4; ++m) { const int grow = cur.pm * BM + ai * HALF + wr * 64 + m * 16 + fr;
                        float sc = sqa[grow];
                        asm volatile("s_waitcnt vmcnt(0)" : "+v"(sc) :: "memory");
#pragma unroll
                        for (int bj = 0; bj < 2; ++bj)
#pragma unroll
                            for (int n = 0; n < 2; ++n) acc[ai][bj][m][n] *= sc;
                        asm volatile("" : "+v"(acc[ai][0][m][0]), "+v"(acc[ai][0][m][1]), "+v"(acc[ai][1][m][0]), "+v"(acc[ai][1][m][1]) :: "memory"); } } }
            if constexpr (SP2) {
            PG8_LDB(B0, 0, 0); PG8_LDB(B1, 0, 1); PG8_SCHED; PG8_LDA(At, 0, 0); PG8_STAGE(PG8_SA(1, 1), a1 + hstep, voffA);
            PG8_WAIT_V(8); PG8_WAIT_L(0); PG8_BAR; PG8_MMA(0, 0, At, B0); PG8_MMA(0, 1, At, B1); PG8_BAR; PG8_SCHED;
            PG8_LDA(At, 0, 1); PG8_STAGE(PG8_SB(0, 0), b2, voffB); PG8_STAGE(PG8_SB(0, 1), b2 + hstep, voffB); PG8_STAGE(PG8_SA(0, 0), a2, voffA);
            PG8_WAIT_V(8); PG8_WAIT_L(0); PG8_BAR; PG8_MMA(1, 0, At, B0); PG8_MMA(1, 1, At, B1); PG8_BAR; PG8_SCHED;
            PG8_LDB(B0, 1, 0); PG8_LDB(B1, 1, 1); PG8_SCHED; PG8_LDA(At, 1, 0); PG8_STAGE(PG8_SA(0, 1), a2 + hstep, voffA);
            PG8_WAIT_V(8); PG8_WAIT_L(0); PG8_BAR; PG8_MMA(0, 0, At, B0); PG8_MMA(0, 1, At, B1); PG8_BAR; PG8_SCHED;
            PG8_LDA(At, 1, 1); PG8_STAGE(PG8_SB(1, 0), b3, voffB); PG8_STAGE(PG8_SB(1, 1), b3 + hstep, voffB); PG8_STAGE(PG8_SA(1, 0), a3, voffA);
            PG8_WAIT_V(8); PG8_WAIT_L(0); PG8_BAR; PG8_MMA(1, 0, At, B0); PG8_MMA(1, 1, At, B1); PG8_BAR; PG8_SCHED;
            } else {
            PG8_LDB(B0, 0, 0); PG8_SCHED; PG8_LDA(At, 0, 0); PG8_STAGE(PG8_SA(1, 1), a1 + hstep, voffA);
            PG8_WAIT_L(8); PG8_BAR; PG8_WAIT_L(0); PG8_MMA(0, 0, At, B0); PG8_BAR; PG8_SCHED;
            PG8_LDB(B1, 0, 1); PG8_STAGE(PG8_SB(0, 0), b2, voffB);
            PG8_BAR; PG8_WAIT_L(0); PG8_MMA(0, 1, At, B1); PG8_BAR;
            PG8_LDA(At, 0, 1); PG8_STAGE(PG8_SA(0, 0), a2, voffA);
            PG8_BAR; PG8_WAIT_L(0); PG8_MMA(1, 0, At, B0); PG8_BAR; PG8_SCHED;
            PG8_STAGE(PG8_SB(0, 1), b2 + hstep, voffB);
            PG8_WAIT_V(6); PG8_BAR; PG8_MMA(1, 1, At, B1); PG8_BAR;
            PG8_LDB(B0, 1, 0); PG8_SCHED; PG8_LDA(At, 1, 0); PG8_STAGE(PG8_SA(0, 1), a2 + hstep, voffA);
            PG8_WAIT_L(8); PG8_BAR; PG8_WAIT_L(0); PG8_MMA(0, 0, At, B0); PG8_BAR; PG8_SCHED;
            PG8_LDB(B1, 1, 1); PG8_STAGE(PG8_SB(1, 0), b3, voffB);
            PG8_BAR; PG8_WAIT_L(0); PG8_MMA(0, 1, At, B1); PG8_BAR;
            PG8_LDA(At, 1, 1); PG8_STAGE(PG8_SA(1, 0), a3, voffA);
            PG8_BAR; PG8_WAIT_L(0); PG8_MMA(1, 0, At, B0); PG8_BAR; PG8_SCHED;
            PG8_STAGE(PG8_SB(1, 1), b3 + hstep, voffB);
            PG8_WAIT_V(6); PG8_BAR; PG8_MMA(1, 1, At, B1); PG8_BAR;
            }
        }
        if constexpr (ALIGN_EPI) { if (wr == 0) PG8_BAR; }
        if constexpr (!Epi::AFTER_DRAIN) { E(acc, cur, wr, wc, fr, fq); S.done(cur); }
        if (!has_next) break;
#pragma unroll
        for (int a = 0; a < 2; ++a)
#pragma unroll
            for (int b = 0; b < 2; ++b)
#pragma unroll
                for (int m = 0; m < 4; ++m)
#pragma unroll
                    for (int n = 0; n < 2; ++n) acc[a][b][m][n] = (f32x4){0.f, 0.f, 0.f, 0.f};
        cur = nxt; cA = nA; cB = nB; ++ui;
        if constexpr (ALIGN_EPI) { if (wr == 1) PG8_BAR; }
    }
    PG8_WAIT_V(0);
    if constexpr (!ALIGN_EPI) { if (wr == 0) PG8_BAR; }
    PG8_BAR;
#undef PG8_SA
#undef PG8_SB
#undef PG8_STAGE
#undef PG8_LDA
#undef PG8_LDB
#undef PG8_MMA
#undef PG8_WAIT_V
#undef PG8_WAIT_L
#undef PG8_BAR
#undef PG8_SCHED
}
}

constexpr int NTOK = 16384, NCTX = 8192, DM = 2048, DIN = 3072, DFF = 8192, DCH = 1024;
constexpr int NMODROW = 9, NMOD = 6 * DM;
constexpr float EPS = 1e-6f;
constexpr int NWAVES = 8, NTHR = 512;
constexpr int LDS_BYTES = 147456;
constexpr int NPH = 13;

constexpr size_t MiB = 1u << 20;
constexpr size_t WS_MOD = 0;
constexpr size_t WS_PE = MiB / 2;
constexpr size_t WS_LB = 1 * MiB;
constexpr size_t WS_BB = 2 * MiB;
constexpr size_t WS_CB = 3 * MiB;
constexpr size_t WS_WSB = 7 * MiB;
constexpr size_t WS_CTL = 4 * MiB, CTL_BYTES = 65536;
constexpr size_t WS_SQV = 5 * MiB + 131072;
constexpr size_t WS_SQA = 5 * MiB, WS_SQB = 5 * MiB + 65536;
constexpr size_t WS_RAT = 6 * MiB;
constexpr int LDS_BARW = LDS_BYTES - 64;
constexpr size_t WS_WFF1 = 8 * MiB, WS_WFF2 = 40 * MiB;
constexpr size_t WS_H = 72 * MiB;
constexpr size_t WS_PROJ = 136 * MiB;
constexpr size_t WS_MIX = 136 * MiB;
constexpr size_t WS_HID = 136 * MiB;
constexpr size_t WS_WIN = 242 * MiB, WS_WGLU = 254 * MiB, WS_WOUT = 256 * MiB;
constexpr size_t WS_AO = 264 * MiB;
constexpr size_t WS_F = 264 * MiB;
constexpr size_t WS_YBPRE = 328 * MiB, WS_YB = 328 * MiB;
constexpr size_t WS_X1B = 328 * MiB;
constexpr size_t WS_END = 392 * MiB;

struct Args { const float* in[30]; float* out; unsigned char* ws; int ph_lo, ph_hi; };
enum { I_XP = 0, I_XS, I_ST, I_C, I_CCTX, I_WADA, I_BADA, I_GPREMIX, I_WIN, I_CWS, I_CBS, I_CGV, I_LRE, I_LIM, I_LDT, I_BRE, I_BIM, I_CRE, I_CIM,
       I_SSMD, I_WGLU, I_BGLU, I_GOA, I_GOB, I_WOUT, I_GPOSTMIX, I_GPREFFN, I_WFF1, I_WFF2, I_GPOSTFFN };

struct TItem { const float* src; bf16_t* dst; int K, N; };
__device__ __forceinline__ void titem_load(const TItem& t, f32x4 (&v)[16], int lane) {
#pragma unroll
    for (int i = 0; i < 16; ++i) v[i] = __builtin_nontemporal_load((const f32x4*)(t.src + (size_t)(4 * i + (lane >> 4)) * t.N + 4 * (lane & 15)));
}
__device__ __forceinline__ void titem_store(const TItem& t, const f32x4 (&v)[16], LAS float* scr, int lane) {
#pragma unroll
    for (int i = 0; i < 16; ++i) { LAS float* s = scr + (4 * i + (lane >> 4)) * 65 + 4 * (lane & 15); s[0] = v[i].x; s[1] = v[i].y; s[2] = v[i].z; s[3] = v[i].w; }
    LDS_WAIT();
    const int c = lane & 7;
#pragma unroll
    for (int j = 0; j < 8; ++j) { const int n = (lane >> 3) + 8 * j; const LAS float* s = scr + (8 * c) * 65 + n;
        u32x4 o; o.x = cvt_pk_bf16(s[0 * 65], s[1 * 65]); o.y = cvt_pk_bf16(s[2 * 65], s[3 * 65]); o.z = cvt_pk_bf16(s[4 * 65], s[5 * 65]); o.w = cvt_pk_bf16(s[6 * 65], s[7 * 65]);
        *(u32x4*)(t.dst + (size_t)n * t.K + 8 * c) = o; }
    LDS_WAIT();
}
__device__ __forceinline__ void ssm_lam(const Args& a, int d, int g, int p, float& lbr, float& lbi, float& cfr, float& cfi) {
    const int ix = (d * 64 + g) * 64 + p;
    const float lr = a.in[I_LRE][ix], li = a.in[I_LIM][ix], dt = expf(a.in[I_LDT][d * 64 + g]);
    const float mag = expf(lr * dt); float sn, cs; sincosf(li * dt, &sn, &cs);
    lbr = mag * cs; lbi = mag * sn;
    const float nr = lbr - 1.f, ni = lbi, den = lr * lr + li * li;
    cfr = (nr * lr + ni * li) / den; cfi = (ni * lr - nr * li) / den;
}

__device__ __forceinline__ void p0_prologue(const Args& a, LAS unsigned char* lds, int tid, int lane, int wave, int G, int B) {
    unsigned char* ws = a.ws;
    if (B < 192) {
        LAS float* sl = (LAS float*)lds + wave * (256 * 9);
        LAS float* red = (LAS float*)lds + NWAVES * 256 * 9;
        const int kbase = wave * 256;
        { float xv[9][4];
#pragma unroll
          for (int r = 0; r < 9; ++r)
#pragma unroll
              for (int q = 0; q < 4; ++q) { const int kl = lane + 64 * q; xv[r][q] = (r == 0) ? a.in[I_CCTX][kbase + kl] : a.in[I_C][(r - 1) * DM + kbase + kl]; }
#pragma unroll
          for (int r = 0; r < 9; ++r)
#pragma unroll
              for (int q = 0; q < 4; ++q) { const float x = xv[r][q]; sl[(lane + 64 * q) * 9 + r] = x / (1.f + __expf(-x)); } }
        LDS_WAIT();
        const int kq = lane >> 4, nl = lane & 15, n0 = 64 * B;
        f32x4 acc[9];
#pragma unroll
        for (int r = 0; r < 9; ++r) acc[r] = (f32x4){0.f, 0.f, 0.f, 0.f};
        const float* wp = a.in[I_WADA] + (size_t)(kbase + kq) * NMOD + n0 + 4 * nl;
#pragma unroll 32
        for (int i = 0; i < 64; ++i) { const f32x4 wv = __builtin_nontemporal_load((const f32x4*)(wp + (size_t)(4 * i) * NMOD));
            const LAS float* s = sl + (4 * i + kq) * 9;
#pragma unroll
            for (int r = 0; r < 9; ++r) acc[r] += wv * s[r]; }
#pragma unroll
        for (int r = 0; r < 9; ++r) {
#pragma unroll
            for (int e = 0; e < 4; ++e) { float v = acc[r][e]; v += __shfl_xor(v, 16); v += __shfl_xor(v, 32); acc[r][e] = v; }
            if (kq == 0) *(LAS f32x4*)(red + (wave * 9 + r) * 64 + 4 * nl) = acc[r];
        }
        LDS_WAIT(); __syncthreads();
        for (int e = tid; e < 9 * 64; e += NTHR) { const int r = e >> 6, cidx = e & 63; float s = a.in[I_BADA][n0 + cidx];
#pragma unroll
            for (int w = 0; w < 8; ++w) s += red[(w * 9 + r) * 64 + cidx];
            ((float*)(ws + WS_MOD))[r * NMOD + n0 + cidx] = s; }
        __syncthreads();
    }
    const int gt = B * NTHR + tid, GT = G * NTHR;
    for (int e = gt; e < 2 * 64 * 64; e += GT) { const int d = e >> 12, g = (e >> 6) & 63, p = e & 63; float lbr, lbi, cr, ci; ssm_lam(a, d, g, p, lbr, lbi, cr, ci);
        ((f32x2*)(ws + WS_LB))[e] = (f32x2){lbr, lbi}; }
    for (int e = gt; e < 2 * 64 * 8 * 64; e += GT) {
        const int l = e & 63, nb = (e >> 6) & 7, g = (e >> 9) & 63, d = e >> 15; const int sr = nb * 16 + (l & 15), p = sr >> 1, im = sr & 1, kq = l >> 4;
        u32x4 o = (u32x4){0u, 0u, 0u, 0u};
        if (kq < 2) { float lbr, lbi, cr, ci; ssm_lam(a, d, g, p, lbr, lbi, cr, ci); float v[8];
#pragma unroll
            for (int i = 0; i < 8; ++i) { const int h = kq * 8 + i; const size_t ix = ((size_t)(d * 64 + g) * 64 + p) * 16 + h; const float br = a.in[I_BRE][ix], bi = a.in[I_BIM][ix];
                v[i] = im ? (cr * bi + ci * br) : (cr * br - ci * bi); }
            o.x = cvt_pk_bf16(v[0], v[1]); o.y = cvt_pk_bf16(v[2], v[3]); o.z = cvt_pk_bf16(v[4], v[5]); o.w = cvt_pk_bf16(v[6], v[7]); }
        ((u32x4*)(ws + WS_BB))[e] = o; }
    for (int e = gt; e < 2 * 64 * 4 * 64; e += GT) {
        const int l = e & 63, kb = (e >> 6) & 3, g = (e >> 8) & 63, d = e >> 14; const int ch = l & 15, k0 = kb * 32 + (l >> 4) * 8; float v[8];
#pragma unroll
        for (int i = 0; i < 8; ++i) { const int k = k0 + i; const size_t ix = ((size_t)(d * 64 + g) * 16 + ch) * 64 + (k >> 1); v[i] = (k & 1) ? -a.in[I_CIM][ix] : a.in[I_CRE][ix]; }
        u32x4 o; o.x = cvt_pk_bf16(v[0], v[1]); o.y = cvt_pk_bf16(v[2], v[3]); o.z = cvt_pk_bf16(v[4], v[5]); o.w = cvt_pk_bf16(v[6], v[7]);
        ((u32x4*)(ws + WS_CB))[e] = o; }
    for (int e = gt; e < 3 * NTOK; e += GT) ((float*)(ws + WS_SQA))[e] = 0.f;
    for (int e = gt; e < 8 * 128 * 128 / 8; e += GT) { const f32x4 v0 = *(const f32x4*)(a.in[I_CWS] + 8 * (size_t)e), v1 = *(const f32x4*)(a.in[I_CWS] + 8 * (size_t)e + 4);
        u32x4 o; o.x = cvt_pk_bf16(v0.x, v0.y); o.y = cvt_pk_bf16(v0.z, v0.w); o.z = cvt_pk_bf16(v1.x, v1.y); o.w = cvt_pk_bf16(v1.z, v1.w); *(u32x4*)((bf16_t*)(ws + WS_WSB) + 8 * (size_t)e) = o; }
    for (int e = gt; e < 80 * 1024; e += GT) { const int r = e >> 10, j = e & 1023; const float pos = (float)(r < 16 ? r : r - 16);
        const float fr = 1.0f / powf(10000.0f, (float)(j & 511) / 512.0f); const float ang = pos * fr;
        ((float*)(ws + WS_PE))[e] = (j < 512) ? sinf(ang) : cosf(ang); }
    LAS float* scr = (LAS float*)(lds + wave * 16640);
    constexpr int IT_IN = (DM / 64) * (DIN / 64), IT_GLU = 16 * 16, IT_OUT = 32 * 32, IT_FF1 = (DM / 64) * (DFF / 64), IT_FF2 = (DFF / 64) * (DM / 64);
    constexpr int NITEMS = IT_IN + IT_GLU + IT_OUT + IT_FF1 + IT_FF2;
    static_assert(NITEMS / 8 > 192 * 5 && NITEMS / 8 <= 192 * 5 + 64 * 7, "static transpose split");
    constexpr int NGRP = NITEMS / 8;
    static_assert(NITEMS % 8 == 0 && IT_IN % 8 == 0 && IT_GLU % 8 == 0 && IT_OUT % 8 == 0 && IT_FF1 % 8 == 0, "item groups");
    int it0, nit;
    if (G == 256) { if (B < 192) { nit = 5; it0 = B * 5; } else { it0 = 192 * 5 + (B - 192) * 7; nit = (it0 + 7 <= NGRP) ? 7 : (it0 < NGRP ? NGRP - it0 : 0); } }
    else { const int per = (NGRP + G - 1) / G; it0 = B * per; nit = (it0 + per <= NGRP) ? per : (it0 < NGRP ? NGRP - it0 : 0); }
    auto mk = [&](int grp) { TItem t; int r = grp; const float* W; bf16_t* WT; int K, N;
        if (r < IT_IN / 8) { W = a.in[I_WIN]; WT = (bf16_t*)(ws + WS_WIN); K = DM; N = DIN; }
        else if ((r -= IT_IN / 8) < IT_GLU / 8) { W = a.in[I_WGLU]; WT = (bf16_t*)(ws + WS_WGLU); K = 1024; N = 1024; }
        else if ((r -= IT_GLU / 8) < IT_OUT / 8) { W = a.in[I_WOUT]; WT = (bf16_t*)(ws + WS_WOUT); K = DM; N = DM; }
        else if ((r -= IT_OUT / 8) < IT_FF1 / 8) { W = a.in[I_WFF1]; WT = (bf16_t*)(ws + WS_WFF1); K = DM; N = DFF; }
        else { r -= IT_FF1 / 8; W = a.in[I_WFF2]; WT = (bf16_t*)(ws + WS_WFF2); K = DFF; N = DM; }
        const int ngn = N / 256, k0 = 64 * (2 * (r / ngn) + (wave & 1)), n0 = 64 * (4 * (r % ngn) + (wave >> 1));
        t.src = W + (size_t)k0 * N + n0; t.dst = WT + (size_t)n0 * K + k0; t.K = K; t.N = N; return t; };
    if (nit > 0) {
        TItem cur = mk(it0); f32x4 vc[16]; titem_load(cur, vc, lane);
#pragma unroll 1
        for (int i = 0; i < nit; ++i) {
            f32x4 vn[16]; TItem nx = cur;
            if (i + 1 < nit) { nx = mk(it0 + i + 1); titem_load(nx, vn, lane); }
            titem_store(cur, vc, scr, lane);
            if (i + 1 < nit) {
#pragma unroll
                for (int k = 0; k < 16; ++k) vc[k] = vn[k];
                cur = nx; }
        }
    }
}

__device__ __forceinline__ void load_x_row(const Args& a, int row, int lane, float (&x)[4][8]) {
    const float* xr = (row < NCTX) ? a.in[I_XP] + (size_t)row * DM : a.in[I_XS] + (size_t)(row - NCTX) * DM;
#pragma unroll
    for (int j = 0; j < 4; ++j) { const f32x4 v0 = __builtin_nontemporal_load((const f32x4*)(xr + 8 * lane + 512 * j)), v1 = __builtin_nontemporal_load((const f32x4*)(xr + 8 * lane + 512 * j + 4));
        x[j][0] = v0.x; x[j][1] = v0.y; x[j][2] = v0.z; x[j][3] = v0.w; x[j][4] = v1.x; x[j][5] = v1.y; x[j][6] = v1.z; x[j][7] = v1.w; }
    if (row >= NCTX) { const int t = (row - NCTX) & 1023; const float* pe = (const float*)(a.ws + WS_PE);
#pragma unroll
        for (int j = 0; j < 4; ++j) { const float* pr = (j < 2) ? pe + (size_t)(t >> 6) * 1024 + 8 * lane + 512 * j : pe + (size_t)(16 + (t & 63)) * 1024 + 8 * lane + 512 * (j - 2);
            const f32x4 v0 = *(const f32x4*)pr, v1 = *(const f32x4*)(pr + 4);
            x[j][0] += v0.x; x[j][1] += v0.y; x[j][2] += v0.z; x[j][3] += v0.w; x[j][4] += v1.x; x[j][5] += v1.y; x[j][6] += v1.z; x[j][7] += v1.w; } }
}
__device__ __forceinline__ void load8(const float* p, float (&v)[8]) { const f32x4 a = *(const f32x4*)p, b = *(const f32x4*)(p + 4); v[0] = a.x; v[1] = a.y; v[2] = a.z; v[3] = a.w; v[4] = b.x; v[5] = b.y; v[6] = b.z; v[7] = b.w; }
__device__ __forceinline__ void load8bf(const bf16_t* p, float (&v)[8]) { const u32x4 w = *(const u32x4*)p; v[0] = bf_lo(w.x); v[1] = bf_hi(w.x); v[2] = bf_lo(w.y); v[3] = bf_hi(w.y); v[4] = bf_lo(w.z); v[5] = bf_hi(w.z); v[6] = bf_lo(w.w); v[7] = bf_hi(w.w); }
__device__ __forceinline__ void store8bf(bf16_t* p, const float (&v)[8]) { u32x4 w; w.x = cvt_pk_bf16(v[0], v[1]); w.y = cvt_pk_bf16(v[2], v[3]); w.z = cvt_pk_bf16(v[4], v[5]); w.w = cvt_pk_bf16(v[6], v[7]); *(u32x4*)p = w; }
__device__ __forceinline__ const float* mod_row(const Args& a, int row) { return (const float*)(a.ws + WS_MOD) + (size_t)((row < NCTX) ? 0 : 1 + ((row - NCTX) >> 10)) * NMOD; }

__device__ __forceinline__ void r1_rows(const Args& a, int gw, int NGW, int lane) {
    bf16_t* H = (bf16_t*)(a.ws + WS_H);
    for (int row0 = 2 * gw; row0 < NTOK; row0 += 2 * NGW) {
        const int rowv[2] = {row0, row0 + 1};
        float x[2][4][8];
#pragma unroll
        for (int u = 0; u < 2; ++u) load_x_row(a, rowv[u], lane, x[u]);
        const float* md = mod_row(a, row0);
        float rstd[2];
#pragma unroll
        for (int u = 0; u < 2; ++u) { float s = 0.f;
#pragma unroll
            for (int j = 0; j < 4; ++j)
#pragma unroll
                for (int e = 0; e < 8; ++e) s += x[u][j][e] * x[u][j][e];
            rstd[u] = rsqrtf(wave_sum(s) * (1.f / DM) + EPS); }
#pragma unroll
        for (int j = 0; j < 4; ++j) { const int c = 8 * lane + 512 * j; float g[8], sh[8], sc[8]; load8(a.in[I_GPREMIX] + c, g); load8(md + c, sh); load8(md + DM + c, sc);
#pragma unroll
            for (int u = 0; u < 2; ++u) { float o[8];
#pragma unroll
                for (int e = 0; e < 8; ++e) o[e] = x[u][j][e] * rstd[u] * g[e] * (1.f + sc[e]) + sh[e];
                store8bf(H + (size_t)rowv[u] * DM + c, o); } }
    }
}
__device__ __forceinline__ void r2_rows(const Args& a, int gw, int NGW, int lane) {
    const bf16_t* Yb = (const bf16_t*)(a.ws + WS_YB); bf16_t* AO = (bf16_t*)(a.ws + WS_AO);
    for (int row0 = gw; row0 < NTOK; row0 += 4 * NGW) {
        int rowv[4]; float y[4][2][8];
#pragma unroll
        for (int u = 0; u < 4; ++u) { rowv[u] = (row0 + u * NGW < NTOK) ? row0 + u * NGW : row0;
#pragma unroll
            for (int j = 0; j < 2; ++j) load8bf(Yb + (size_t)rowv[u] * DCH + 8 * lane + 512 * j, y[u][j]); }
#pragma unroll
        for (int u = 0; u < 4; ++u) { const int row = rowv[u]; float s = 0.f;
#pragma unroll
            for (int j = 0; j < 2; ++j)
#pragma unroll
                for (int e = 0; e < 8; ++e) s += y[u][j][e] * y[u][j][e];
            const float rstd = rsqrtf(wave_sum(s) * (1.f / DCH) + EPS);
#pragma unroll
            for (int j = 0; j < 2; ++j) { const int c = 8 * lane + 512 * j; float g[8], o[8]; load8(a.in[I_GOB] + c, g);
#pragma unroll
                for (int e = 0; e < 8; ++e) o[e] = y[u][j][e] * rstd * g[e];
                store8bf(AO + (size_t)row * DM + DCH + c, o); } }
    }
}
__device__ __forceinline__ void r3_rows(const Args& a, int gw, int NGW, int lane) {
    const bf16_t* MX = (const bf16_t*)(a.ws + WS_MIX); bf16_t* H = (bf16_t*)(a.ws + WS_H);
    for (int row0 = 2 * gw; row0 < NTOK; row0 += 2 * NGW) {
        const int rowv[2] = {row0, row0 + 1};
        float x[2][4][8], m[2][4][8];
#pragma unroll
        for (int u = 0; u < 2; ++u) { load_x_row(a, rowv[u], lane, x[u]);
#pragma unroll
            for (int j = 0; j < 4; ++j) load8bf(MX + (size_t)rowv[u] * DM + 8 * lane + 512 * j, m[u][j]); }
        const float* md = mod_row(a, row0);
        float rstd[2], s2[2] = {0.f, 0.f};
#pragma unroll
        for (int u = 0; u < 2; ++u) { float s = 0.f;
#pragma unroll
            for (int j = 0; j < 4; ++j)
#pragma unroll
                for (int e = 0; e < 8; ++e) s += m[u][j][e] * m[u][j][e];
            rstd[u] = rsqrtf(wave_sum(s) * (1.f / DM) + EPS); }
#pragma unroll
        for (int j = 0; j < 4; ++j) { const int c = 8 * lane + 512 * j; float g[8], gt[8]; load8(a.in[I_GPOSTMIX] + c, g); load8(md + 2 * DM + c, gt);
#pragma unroll
            for (int u = 0; u < 2; ++u) {
#pragma unroll
                for (int e = 0; e < 8; ++e) { x[u][j][e] += gt[e] * (m[u][j][e] * rstd[u] * g[e]); s2[u] += x[u][j][e] * x[u][j][e]; }
                store8bf((bf16_t*)(a.ws + WS_X1B) + (size_t)rowv[u] * DM + c, x[u][j]); } }
        float rstd2[2];
#pragma unroll
        for (int u = 0; u < 2; ++u) rstd2[u] = rsqrtf(wave_sum(s2[u]) * (1.f / DM) + EPS);
#pragma unroll
        for (int j = 0; j < 4; ++j) { const int c = 8 * lane + 512 * j; float g[8], sh[8], sc[8]; load8(a.in[I_GPREFFN] + c, g); load8(md + 3 * DM + c, sh); load8(md + 4 * DM + c, sc);
#pragma unroll
            for (int u = 0; u < 2; ++u) { float o[8];
#pragma unroll
                for (int e = 0; e < 8; ++e) o[e] = x[u][j][e] * rstd2[u] * g[e] * (1.f + sc[e]) + sh[e];
                store8bf(H + (size_t)rowv[u] * DM + c, o); } }
    }
}
__device__ __forceinline__ void r4_rows(const Args& a, int gw, int NGW, int lane) {
    const bf16_t* F = (const bf16_t*)(a.ws + WS_F);
    for (int row0 = 2 * gw; row0 < NTOK; row0 += 2 * NGW) {
        const int rowv[2] = {row0, row0 + 1};
        float f[2][4][8], x1[2][4][8];
#pragma unroll
        for (int u = 0; u < 2; ++u)
#pragma unroll
            for (int j = 0; j < 4; ++j) { load8bf(F + (size_t)rowv[u] * DM + 8 * lane + 512 * j, f[u][j]); load8bf((const bf16_t*)(a.ws + WS_X1B) + (size_t)rowv[u] * DM + 8 * lane + 512 * j, x1[u][j]); }
        const float* md = mod_row(a, row0);
        float rstd[2];
#pragma unroll
        for (int u = 0; u < 2; ++u) { float s = 0.f;
#pragma unroll
            for (int j = 0; j < 4; ++j)
#pragma unroll
                for (int e = 0; e < 8; ++e) s += f[u][j][e] * f[u][j][e];
            rstd[u] = rsqrtf(wave_sum(s) * (1.f / DM) + EPS); }
#pragma unroll
        for (int j = 0; j < 4; ++j) { const int c = 8 * lane + 512 * j; float g[8], gt[8]; load8(a.in[I_GPOSTFFN] + c, g); load8(md + 5 * DM + c, gt);
#pragma unroll
            for (int u = 0; u < 2; ++u) { float* o = a.out + (size_t)rowv[u] * DM + c;
#pragma unroll
                for (int e = 0; e < 8; ++e) x1[u][j][e] += gt[e] * (f[u][j][e] * rstd[u] * g[e]);
                __builtin_nontemporal_store((f32x4){x1[u][j][0], x1[u][j][1], x1[u][j][2], x1[u][j][3]}, (f32x4*)o); __builtin_nontemporal_store((f32x4){x1[u][j][4], x1[u][j][5], x1[u][j][6], x1[u][j][7]}, (f32x4*)(o + 4)); } }
    }
}

__device__ __forceinline__ float gelu_tanh(float v) { const float u = 1.5957691216f * (v + 0.044715f * v * v * v); return v * __builtin_amdgcn_rcpf(1.f + __expf(-u)); }

template <int DIR, int MODE>
__device__ __forceinline__ void ssm_task(const Args& a, LAS unsigned char* wl, LAS unsigned char* yl, int b, int g, int lane) {
    constexpr bool lat = (MODE == 0);
    const int L = lat ? 1024 : 256; const int rowbase = lat ? NCTX + b * 1024 : b * 256;
    LAS float* S = (LAS float*)wl;
    LAS bf16_t* Hs = (LAS bf16_t*)(wl + 16 * 132 * 4);
    bf16x8 bb[8], cb[4];
    { const bf16x8* p = (const bf16x8*)(a.ws + WS_BB) + (size_t)((DIR * 64 + g) * 8) * 64 + lane;
#pragma unroll
      for (int nb = 0; nb < 8; ++nb) bb[nb] = p[nb * 64]; }
    { const bf16x8* p = (const bf16x8*)(a.ws + WS_CB) + (size_t)((DIR * 64 + g) * 4) * 64 + lane;
#pragma unroll
      for (int kb = 0; kb < 4; ++kb) cb[kb] = p[kb * 64]; }
    const f32x2 lam = ((const f32x2*)(a.ws + WS_LB))[(DIR * 64 + g) * 64 + lane];
    f32x2 h = (f32x2){0.f, 0.f};
    if (lat) { const float* st = a.in[I_ST] + (size_t)((b * 2 + DIR) * 2) * 4096 + g * 64 + lane; h.x = st[0]; h.y = st[4096]; }
    const f32x2 lamx = (f32x2){lam.x, lam.x}, lamy = (f32x2){-lam.y, lam.y};
    const bf16_t* ub = (const bf16_t*)(a.ws + WS_PROJ) + (size_t)rowbase * DIN + 2048 + g * 16 + ((lane >> 4) & 1) * 8;
    float* yp = a.out + (size_t)DIR * NTOK * DCH + (size_t)rowbase * DCH + g * 16 + (lane >> 4) * 4;
    const int nt = L / 16;
#define SSM_T0(i_) ((DIR ? nt - 1 - (i_) : (i_)) * 16)
    const bf16_t* uwb = (const bf16_t*)(a.ws + WS_PROJ) + (size_t)rowbase * DIN + 2048 + g * 16 + (lane >> 4) * 4;
    const f32x4 dsk = *(const f32x4*)(a.in[I_SSMD] + g * 16 + (lane >> 4) * 4);
    auto load_u = [&](const int i_) __attribute__((always_inline)) { return *(const bf16x8*)(ub + (size_t)(SSM_T0(i_) + (lane & 15)) * DIN); };
    auto load_uw = [&](const int i_) __attribute__((always_inline)) { return *(const u32x2*)(uwb + (size_t)(SSM_T0(i_) + (lane & 15)) * DIN); };
    auto stage_bu = [&](const bf16x8 uf) __attribute__((always_inline)) {
#pragma unroll
        for (int nb = 0; nb < 8; ++nb) { const f32x4 acc = __builtin_amdgcn_mfma_f32_16x16x32_bf16(bb[nb], uf, (f32x4){0.f, 0.f, 0.f, 0.f}, 0, 0, 0);
            u32x2 o; o.x = cvt_pk_bf16(acc[0], acc[1]); o.y = cvt_pk_bf16(acc[2], acc[3]);
            *(LAS u32x2*)((LAS unsigned*)S + (lane & 15) * 68 + nb * 8 + (lane >> 4) * 2) = o; } };
    auto read_bu = [&](f32x2 (&bu)[16]) __attribute__((always_inline)) {
#pragma unroll
        for (int s = 0; s < 16; ++s) { const unsigned w = ((const LAS unsigned*)S)[(DIR ? 15 - s : s) * 68 + lane]; bu[s] = (f32x2){bf_lo(w), bf_hi(w)}; } };
    auto scan = [&](const f32x2 (&bu)[16]) __attribute__((always_inline)) {
#pragma unroll
        for (int s = 0; s < 16; ++s) { const int tt = DIR ? 15 - s : s;
            const f32x2 t1 = lamx * h + bu[s]; h = lamy * __builtin_shufflevector(h, h, 1, 0) + t1;
            ((LAS unsigned*)Hs)[tt * 68 + lane] = cvt_pk_bf16(h.x, h.y); } };
    auto emit_y = [&](const int i_, const u32x2 uw) __attribute__((always_inline)) {
        const int t0 = SSM_T0(i_);
        f32x4 y = (f32x4){0.f, 0.f, 0.f, 0.f};
#pragma unroll
        for (int kb = 0; kb < 4; ++kb) { const bf16x8 hf = __builtin_bit_cast(bf16x8, *(const LAS u32x4*)(Hs + (lane & 15) * 136 + kb * 32 + (lane >> 4) * 8));
            y = __builtin_amdgcn_mfma_f32_16x16x32_bf16(cb[kb], hf, y, 0, 0, 0); }
        if constexpr (MODE == 0) *(f32x4*)(yp + (size_t)(t0 + (lane & 15)) * DCH) = y;
        if constexpr (MODE == 1) { u32x2 o; o.x = cvt_pk_bf16(y[0], y[1]); o.y = cvt_pk_bf16(y[2], y[3]); *(LAS u32x2*)(yl + (t0 + (lane & 15)) * 32 + (lane >> 4) * 8) = o; }
        if constexpr (MODE == 2) { const u32x2 yw = *(const LAS u32x2*)(yl + (t0 + (lane & 15)) * 32 + (lane >> 4) * 8);
            const size_t row = (size_t)(rowbase + t0 + (lane & 15)); const int ch = g * 16 + (lane >> 4) * 4; const f32x4 d = dsk;
            const float v0 = gelu_tanh(bf_lo(yw.x) + y[0] + d.x * bf_lo(uw.x)), v1 = gelu_tanh(bf_hi(yw.x) + y[1] + d.y * bf_hi(uw.x)), v2 = gelu_tanh(bf_lo(yw.y) + y[2] + d.z * bf_lo(uw.y)), v3 = gelu_tanh(bf_hi(yw.y) + y[3] + d.w * bf_hi(uw.y));
            u32x2 o; o.x = cvt_pk_bf16(v0, v1); o.y = cvt_pk_bf16(v2, v3); *(u32x2*)((bf16_t*)(a.ws + WS_YBPRE) + row * DCH + ch) = o; } };
    bf16x8 un = load_u(0);
    u32x2 uwc = (u32x2){0u, 0u}, uwn = (u32x2){0u, 0u};
    if (MODE == 2) uwn = load_uw(0);
    stage_bu(un);
    un = load_u(1);
    { f32x2 bu[16]; read_bu(bu); const bf16x8 uf = un; un = load_u(2); stage_bu(uf); scan(bu); uwc = uwn; if (MODE == 2) uwn = load_uw(1); }
#pragma unroll 1
    for (int i = 1; i < nt - 1; ++i) {
        f32x2 bu[16]; read_bu(bu);
        const bf16x8 uf = un; un = load_u((i + 2 < nt) ? i + 2 : nt - 1);
        stage_bu(uf);
        emit_y(i - 1, uwc);
        scan(bu);
        uwc = uwn; if (MODE == 2) uwn = load_uw(i + 1);
    }
    { f32x2 bu[16]; read_bu(bu); emit_y(nt - 2, uwc); scan(bu); uwc = uwn; }
    emit_y(nt - 1, uwc);
#undef SSM_T0
    if (!lat) { float* o = a.out + (size_t)NTOK * DM + (size_t)((b * 2 + DIR) * 2) * 4096 + g * 64 + lane; o[0] = h.x; o[4096] = h.y; }
}

__device__ __forceinline__ void ssm_phase(const Args& a, LAS unsigned char* lds, int tid, int lane, int wave, int B) {
    LAS unsigned char* wl = lds + wave * 12800;
    LAS unsigned char* yl = lds + NWAVES * 12800 + (wave & 3) * 8192;
    volatile LAS unsigned* pflag = (volatile LAS unsigned*)(lds + NWAVES * 12800 + 4 * 8192);
    if (tid < 2) pflag[tid] = 0u;
    LDS_WAIT(); __syncthreads();
    if (wave < 4) { const int pl = wave >> 1, pair = 2 * B + pl; const int b = pair >> 6, g = pair & 63;
        if (wave & 1) ssm_task<1, 0>(a, wl, yl, b, g, lane); else ssm_task<0, 0>(a, wl, yl, b, g, lane);
        VM_WAIT();
        if (lane == 0) __hip_atomic_fetch_add((LAS unsigned*)(pflag + pl), 1u, __ATOMIC_RELAXED, __HIP_MEMORY_SCOPE_WORKGROUP);
        { unsigned spins = 0; while (pflag[pl] < 2u && ++spins < (1u << 22)) __builtin_amdgcn_s_sleep(4); }
        asm volatile("" ::: "memory");
        const float* y0 = a.out; const float* y1 = a.out + (size_t)NTOK * DCH;
        const bf16_t* proj = (const bf16_t*)(a.ws + WS_PROJ); bf16_t* YP = (bf16_t*)(a.ws + WS_YBPRE);
        const int rowbase = NCTX + b * 1024 + (wave & 1) * 512, ch = g * 16 + 4 * (lane & 3);
        const f32x4 d = *(const f32x4*)(a.in[I_SSMD] + ch);
#pragma unroll 8
        for (int it = 0; it < 32; ++it) { const int row = rowbase + it * 16 + (lane >> 2);
            const f32x4 yf = *(const f32x4*)(y0 + (size_t)row * DCH + ch), yb = *(const f32x4*)(y1 + (size_t)row * DCH + ch);
            const u32x2 uw = *(const u32x2*)(proj + (size_t)row * DIN + 2048 + ch);
            const float v0 = gelu_tanh(yf.x + yb.x + d.x * bf_lo(uw.x)), v1 = gelu_tanh(yf.y + yb.y + d.y * bf_hi(uw.x)), v2 = gelu_tanh(yf.z + yb.z + d.z * bf_lo(uw.y)), v3 = gelu_tanh(yf.w + yb.w + d.w * bf_hi(uw.y));
            u32x2 o; o.x = cvt_pk_bf16(v0, v1); o.y = cvt_pk_bf16(v2, v3); *(u32x2*)(YP + (size_t)row * DCH + ch) = o; }
    } else {
#pragma unroll 1
        for (int q = 0; q < 2; ++q) { const int pair = 8 * B + 2 * (wave - 4) + q; const int b = pair >> 6, g = pair & 63;
            ssm_task<0, 1>(a, wl, yl, b, g, lane); ssm_task<1, 2>(a, wl, yl, b, g, lane); }
    }
    VM_WAIT(); __syncthreads();
}

__device__ __forceinline__ void chunk_unit(const Args& a, LAS unsigned char* lds, int tid, int lane, int wave, int unit) {
    LAS bf16_t* Ws = (LAS bf16_t*)lds;
    LAS bf16_t* Vt = (LAS bf16_t*)(lds + 128 * 136 * 2);
    LAS float* rstdv = (LAS float*)(lds + 2 * 128 * 136 * 2);
    const bf16_t* proj = (const bf16_t*)(a.ws + WS_PROJ); bf16_t* AO = (bf16_t*)(a.ws + WS_AO);
    const int r0 = (unit >> 1) * 128, h0 = (unit & 1) * 4;
    if (tid < 128) rstdv[tid] = rsqrtf(((const float*)(a.ws + WS_SQV))[r0 + tid] * (1.f / DCH) + EPS);
    const int wr = wave >> 2, wc = wave & 3, fr = lane & 15, fq = lane >> 4;
    float rs[4] = {0.f, 0.f, 0.f, 0.f};
    u32x4 wreg[4]; u32x4 vreg[4];
#define CH_LOAD(h) do { const bf16_t* wsrc = (const bf16_t*)(a.ws + WS_WSB) + (size_t)(h) * 16384; \
        _Pragma("unroll") for (int i = 0; i < 4; ++i) { const int idx = tid + NTHR * i; wreg[i] = *(const u32x4*)(wsrc + (idx >> 4) * 128 + 8 * (idx & 15)); } \
        _Pragma("unroll") for (int i = 0; i < 4; ++i) { const int c = tid + NTHR * i; vreg[i] = *(const u32x4*)(proj + (size_t)(r0 + (c & 127)) * DIN + 1024 + (h) * 128 + 8 * (c >> 7)); } } while (0)
    CH_LOAD(h0);
    LDS_WAIT(); __syncthreads();
#pragma unroll 1
    for (int hh = 0; hh < 4; ++hh) { const int h = h0 + hh;
#pragma unroll
        for (int i = 0; i < 4; ++i) { const int idx = tid + NTHR * i, p = idx >> 4, q8 = idx & 15; *(LAS u32x4*)(Ws + p * 136 + 8 * q8) = wreg[i]; }
#pragma unroll
        for (int i = 0; i < 4; ++i) { const int c = tid + NTHR * i, q = c & 127, d8 = c >> 7; float g[8]; const u32x4 w = vreg[i];
            const float v[8] = {bf_lo(w.x), bf_hi(w.x), bf_lo(w.y), bf_hi(w.y), bf_lo(w.z), bf_hi(w.z), bf_lo(w.w), bf_hi(w.w)};
            load8(a.in[I_CGV] + h * 128 + 8 * d8, g); const float rv = rstdv[q];
#pragma unroll
            for (int e = 0; e < 8; e += 2) { const unsigned pk = cvt_pk_bf16(v[e] * rv * g[e], v[e + 1] * rv * g[e + 1]);
                Vt[(8 * d8 + e) * 136 + q] = (bf16_t)(pk & 0xffffu); Vt[(8 * d8 + e + 1) * 136 + q] = (bf16_t)(pk >> 16); } }
        u32x2 uwv[4][2];
#pragma unroll
        for (int m = 0; m < 4; ++m)
#pragma unroll
            for (int n = 0; n < 2; ++n) uwv[m][n] = *(const u32x2*)(proj + (size_t)(r0 + 64 * wr + 16 * m + fr) * DIN + h * 128 + 32 * wc + 16 * n + 4 * fq);
        if (hh + 1 < 4) CH_LOAD(h + 1);
        LDS_WAIT(); __syncthreads();
        f32x4 acc[4][2];
#pragma unroll
        for (int m = 0; m < 4; ++m)
#pragma unroll
            for (int n = 0; n < 2; ++n) acc[m][n] = (f32x4){0.f, 0.f, 0.f, 0.f};
#pragma unroll
        for (int ks = 0; ks < 4; ++ks) { bf16x8 af[4], bfr[2];
#pragma unroll
            for (int m = 0; m < 4; ++m) af[m] = *(const LAS bf16x8*)(Ws + (64 * wr + 16 * m + fr) * 136 + ks * 32 + fq * 8);
#pragma unroll
            for (int n = 0; n < 2; ++n) bfr[n] = *(const LAS bf16x8*)(Vt + (32 * wc + 16 * n + fr) * 136 + ks * 32 + fq * 8);
#pragma unroll
            for (int m = 0; m < 4; ++m)
#pragma unroll
                for (int n = 0; n < 2; ++n) acc[m][n] = __builtin_amdgcn_mfma_f32_16x16x32_bf16(bfr[n], af[m], acc[m][n], 0, 0, 0); }
        f32x4 g4v[2];
#pragma unroll
        for (int n = 0; n < 2; ++n) g4v[n] = *(const f32x4*)(a.in[I_GOA] + h * 128 + 32 * wc + 16 * n + 4 * fq);
#pragma unroll
        for (int m = 0; m < 4; ++m) { const int p = 64 * wr + 16 * m + fr; const float bs = a.in[I_CBS][h * 128 + p];
#pragma unroll
            for (int n = 0; n < 2; ++n) { const int d = 32 * wc + 16 * n + 4 * fq; const u32x2 uw = uwv[m][n]; const f32x4 g4 = g4v[n];
                const float y0 = bf_lo(uw.x) * (acc[m][n][0] + bs), y1 = bf_hi(uw.x) * (acc[m][n][1] + bs), y2 = bf_lo(uw.y) * (acc[m][n][2] + bs), y3 = bf_hi(uw.y) * (acc[m][n][3] + bs);
                rs[m] += (y0 * y0 + y1 * y1) + (y2 * y2 + y3 * y3);
                u32x2 o; o.x = cvt_pk_bf16(y0 * g4.x, y1 * g4.y); o.y = cvt_pk_bf16(y2 * g4.z, y3 * g4.w); *(u32x2*)(AO + (size_t)(r0 + p) * DM + h * 128 + d) = o; } }
        __syncthreads();
    }
#undef CH_LOAD
    float* sqa = (float*)(a.ws + WS_SQA);
#pragma unroll
    for (int m = 0; m < 4; ++m) { float s = rs[m]; s += __shfl_xor(s, 16); s += __shfl_xor(s, 32); if (fq == 0) atomicAdd(sqa + r0 + 64 * wr + 16 * m + fr, s); }
}

#define XB_TMO      128
#define XB_XCNT(j)  (256  + 64 * (j))
#define XB_XSUB(j)  (1280 + 64 * (j))
#define XB_XGEN(j)  (2304 + 64 * (j))
#define XB_TOP      3328
#define XB_TOPGEN   3392
#define XCD_BAR_WORDS 3456
#define XB_SPIN_CAP (1u << 22)
__device__ __forceinline__ unsigned xb_ld(unsigned* p)              { return __hip_atomic_load(p, __ATOMIC_RELAXED, __HIP_MEMORY_SCOPE_AGENT); }
__device__ __forceinline__ unsigned xb_add(unsigned* p, unsigned v) { return __hip_atomic_fetch_add(p, v, __ATOMIC_RELAXED, __HIP_MEMORY_SCOPE_AGENT); }
__device__ __forceinline__ unsigned xb_xcc_id() { return (unsigned)__builtin_amdgcn_s_getreg((3 << 11) | 20) & 0xFu; }
#define XB_SPIN(cond, bar) do { unsigned _sp = 0; while (cond) { __builtin_amdgcn_s_sleep(1); \
    if ((++_sp & 255u) == 0u) { if (xb_ld(&(bar)[XB_TMO])) break; if (_sp > XB_SPIN_CAP) { atomicAdd(&(bar)[XB_TMO], 1u); break; } } } } while (0)
struct XcdBarrier { unsigned* bar; unsigned x; volatile LAS unsigned* st; };
__device__ __forceinline__ XcdBarrier xcd_barrier_post(unsigned* bar, volatile LAS unsigned* st) {
    XcdBarrier b; b.bar = bar; b.x = xb_xcc_id(); b.st = st;
    if (threadIdx.x == 0) (void)xb_add(&bar[XB_XCNT(b.x)], 1u);
    return b;
}
__device__ __forceinline__ void xcd_barrier_complete(unsigned* bar, unsigned x, unsigned& nloc, unsigned& nx) {
    const unsigned G = gridDim.x * gridDim.y * gridDim.z;
    unsigned sum, cnt, mine, sp = 0u;
    for (;;) {
        sum = 0u; cnt = 0u; mine = 0u;
#pragma unroll
        for (unsigned j = 0; j < 16; ++j) { const unsigned c = xb_ld(&bar[XB_XCNT(j)]); sum += c; cnt += (c > 0u) ? 1u : 0u; mine = (j == x) ? c : mine; }
        if (sum == G) break;
        __builtin_amdgcn_s_sleep(1);
        if ((++sp & 255u) == 0u) { if (xb_ld(&bar[XB_TMO])) break; if (sp > XB_SPIN_CAP) { atomicAdd(&bar[XB_TMO], 1u); break; } }
    }
    nloc = mine > 0u ? mine : 1u; nx = cnt > 0u ? cnt : 1u;
}
__device__ __forceinline__ void xcd_barrier(const XcdBarrier& b) {
    asm volatile("s_waitcnt vmcnt(0)" ::: "memory");
    __syncthreads();
    if (threadIdx.x == 0) {
        unsigned* bar = b.bar;
        __builtin_amdgcn_s_waitcnt(0);
        unsigned nloc = b.st[0], nx = b.st[1];
        if (nloc == 0u) { xcd_barrier_complete(bar, b.x, nloc, nx); b.st[0] = nloc; b.st[1] = nx; }
        const unsigned old = xb_add(&bar[XB_XSUB(b.x)], 1u);
        const unsigned gen = old / nloc;
        if (old + 1u == (gen + 1u) * nloc) {
            __builtin_amdgcn_fence(__ATOMIC_RELEASE, "agent");
            asm volatile("s_waitcnt vmcnt(0)" ::: "memory");
            const unsigned og = xb_add(&bar[XB_TOP], 1u);
            const unsigned tg = og / nx;
            if (og + 1u == (tg + 1u) * nx) xb_add(&bar[XB_TOPGEN], 1u);
            else XB_SPIN(xb_ld(&bar[XB_TOPGEN]) == tg, bar);
            __builtin_amdgcn_fence(__ATOMIC_ACQUIRE, "agent");
            xb_add(&bar[XB_XGEN(b.x)], 1u);
            asm volatile("s_waitcnt vmcnt(0)" ::: "memory");
        } else {
            XB_SPIN(xb_ld(&bar[XB_XGEN(b.x)]) == gen, bar);
            __builtin_amdgcn_fence(__ATOMIC_ACQUIRE, "agent");
            asm volatile("s_waitcnt vmcnt(0)" ::: "memory");
        }
    }
    __syncthreads();
}

__global__ void __launch_bounds__(NTHR, 2) fwd_kernel(Args a) {
    extern __shared__ __attribute__((aligned(16))) unsigned char lds_raw[];
    LAS unsigned char* lds = (LAS unsigned char*)lds_raw;
    const int tid = threadIdx.x, lane = tid & 63, wave = __builtin_amdgcn_readfirstlane(tid >> 6);
    const int G = gridDim.x, B = blockIdx.x;
    const int gw = B * NWAVES + wave, NGW = G * NWAVES;
    const int lo = a.ph_lo, hi = a.ph_hi;
    unsigned char* ws = a.ws;
#ifndef PH_MASK
#define PH_MASK 0xFFFF
#endif
#define IN(k) (((PH_MASK >> (k)) & 1) && lo <= (k) && (k) < hi)
    volatile LAS unsigned* bst = (volatile LAS unsigned*)(lds + LDS_BARW);
    if (tid == 0) { bst[0] = 0u; bst[1] = 0u; }
    __syncthreads();
    XcdBarrier xbar = xcd_barrier_post((unsigned*)(ws + WS_CTL), bst);
#define SEAM(k) do { if (IN(k) && IN((k) + 1)) { xcd_barrier(xbar); } } while (0)
#ifndef REP_MASK
#define REP_MASK 0
#endif
#define REP(k) (((REP_MASK >> (k)) & 1) ? 2 : 1)
#define RSYNC(k, r) do { if (r + 1 < REP(k)) xcd_barrier(xbar); } while (0)

    if (IN(0)) { for (int r = 0; r < REP(0); ++r) { p0_prologue(a, lds, tid, lane, wave, G, B); RSYNC(0, r); } } SEAM(0);
    if (IN(1)) { for (int r = 0; r < REP(1); ++r) { r1_rows(a, gw, NGW, lane); RSYNC(1, r); } } SEAM(1);
    if (IN(2)) { pg8::Gemm g{(const bf16_t*)(ws + WS_H), (const bf16_t*)(ws + WS_WIN), NTOK, DIN, DM}; pg8::StaticOrder S; S.init(NTOK, DIN, G, B);
        pg8::EpiB<4> E{(bf16_t*)(ws + WS_PROJ), DIN, nullptr, nullptr, 0, nullptr, (float*)(ws + WS_SQV)};
        pg8::gemm_phase<pg8::EpiB<4>, pg8::StaticOrder, true, true>(lds, g, S, E); } SEAM(2);
    #ifndef REP_SSM
#define REP_SSM 1
#endif
#ifndef REP_CH
#define REP_CH 1
#endif
    if (IN(3)) {
#pragma unroll 1
        for (int r = 0; r < REP_SSM; ++r) ssm_phase(a, lds, tid, lane, wave, B);
#pragma unroll 1
        for (int r = 0; r < REP_CH; ++r) for (int u = B; u < 256; u += G) chunk_unit(a, lds, tid, lane, wave, u);
    } SEAM(3);
    if (IN(4)) { pg8::Gemm g{(const bf16_t*)(ws + WS_YBPRE), (const bf16_t*)(ws + WS_WGLU), NTOK, DCH, DCH}; pg8::StaticOrder S; S.init(NTOK, DCH, G, B);
        pg8::EpiB<2> E{(bf16_t*)(ws + WS_AO) + DCH, DM, a.in[I_BGLU], (const bf16_t*)(ws + WS_YBPRE), DCH, a.in[I_GOB], (float*)(ws + WS_SQB)};
        for (int r = 0; r < REP(4); ++r) { pg8::gemm_phase<pg8::EpiB<2>, pg8::StaticOrder, true, true>(lds, g, S, E); RSYNC(4, r); } } SEAM(4);
    if (IN(6)) { pg8::Gemm g{(const bf16_t*)(ws + WS_AO), (const bf16_t*)(ws + WS_WOUT), NTOK, DM, DM}; pg8::StaticOrder S; S.init(NTOK, DM, G, B);
        { float* sqa = (float*)(ws + WS_SQA); float* sqb = (float*)(ws + WS_SQB); float* rat = (float*)(ws + WS_RAT); float* rbv = rat + NTOK; pg8::Unit u;
          for (int i = 0; S.next(i, u); ++i) if (tid < 256) { const int row = u.pm * 256 + tid; const float ra = rsqrtf(sqa[row] * (1.f / 1024.f) + EPS), rb = rsqrtf(sqb[row] * (1.f / 1024.f) + EPS); rat[row] = ra / rb; rbv[row] = rb; }
          VM_WAIT(); __syncthreads(); }
        pg8::EpiB<3> E{(bf16_t*)(ws + WS_MIX), DM, nullptr, nullptr, 0, nullptr, (float*)(ws + WS_RAT) + NTOK};
        for (int r = 0; r < REP(6); ++r) { pg8::gemm_phase<pg8::EpiB<3>, pg8::StaticOrder, true, true, true>(lds, g, S, E, (const float*)(ws + WS_RAT), nullptr); RSYNC(6, r); } } SEAM(6);
    if (IN(7)) { for (int r = 0; r < REP(7); ++r) { r3_rows(a, gw, NGW, lane); RSYNC(7, r); } } SEAM(7);
#pragma unroll
    for (int half = 0; half < 2; ++half) {
        const size_t rofs = (size_t)half * 8192;
        if (IN(8 + 2 * half)) { pg8::Gemm g{(const bf16_t*)(ws + WS_H) + rofs * DM, (const bf16_t*)(ws + WS_WFF1), 8192, DFF, DM}; pg8::StaticOrder S; S.init(8192, DFF, G, B);
            pg8::EpiB<1> E{(bf16_t*)(ws + WS_HID), DFF, nullptr, nullptr, 0, nullptr, nullptr};
            for (int r = 0; r < REP(8); ++r) { pg8::gemm_phase<pg8::EpiB<1>, pg8::StaticOrder, true, true>(lds, g, S, E); RSYNC(8, r); } } SEAM(8 + 2 * half);
        if (IN(9 + 2 * half)) { pg8::Gemm g{(const bf16_t*)(ws + WS_HID), (const bf16_t*)(ws + WS_WFF2), 8192, DM, DFF}; pg8::StaticOrder S; S.init(8192, DM, G, B);
            pg8::EpiB<0> E{(bf16_t*)(ws + WS_F) + rofs * DM, DM, nullptr, nullptr, 0, nullptr, nullptr};
            for (int r = 0; r < REP(9); ++r) { pg8::gemm_phase<pg8::EpiB<0>, pg8::StaticOrder, true, true>(lds, g, S, E); RSYNC(9, r); } } SEAM(9 + 2 * half);
    }
    if (IN(12)) { r4_rows(a, gw, NGW, lane); }
    if (a.ph_hi < 0) cg::this_grid().sync();
#undef IN
#undef SEAM
}

extern "C" void kernel_launch(void* const* d_in, const int* in_sizes, int n_in, void* d_out, int out_size, void* d_ws, size_t ws_size, hipStream_t stream) {
    static int grid = 0;
    if (grid == 0) {
        if (n_in != 30 || ws_size < WS_END) { fprintf(stderr, "kernel_launch: unexpected n_in %d / ws_size %zu (need %zu)\n", n_in, ws_size, (size_t)WS_END); grid = -1; return; }
        int dev = 0, cus = 0, per_cu = 0;
        hipGetDevice(&dev); hipDeviceGetAttribute(&cus, hipDeviceAttributeMultiprocessorCount, dev);
        hipFuncSetAttribute((const void*)fwd_kernel, hipFuncAttributeMaxDynamicSharedMemorySize, LDS_BYTES);
        hipOccupancyMaxActiveBlocksPerMultiprocessor(&per_cu, (const void*)fwd_kernel, NTHR, LDS_BYTES);
        if (per_cu < 1) per_cu = 1;
        (void)hipGetLastError();
        grid = cus * per_cu;
        if (grid > 256) grid = 256;
    }
    if (grid < 0) return;
    (void)hipMemsetAsync((unsigned char*)d_ws + WS_CTL, 0, CTL_BYTES, stream);
    Args a{};
    for (int i = 0; i < 30; ++i) a.in[i] = (const float*)d_in[i];
    a.out = (float*)d_out; a.ws = (unsigned char*)d_ws;
#if MK_MULTI
    for (int p = 0; p < NPH; ++p) { a.ph_lo = p; a.ph_hi = p + 1; hipLaunchKernelGGL(fwd_kernel, dim3(grid), dim3(NTHR), LDS_BYTES, stream, a); }
#else
    a.ph_lo = 0; a.ph_hi = NPH;
    void* args[] = {&a};
    hipError_t e = hipLaunchCooperativeKernel((const void*)fwd_kernel, dim3(grid), dim3(NTHR), args, LDS_BYTES, stream);
    if (e != hipSuccess) fprintf(stderr, "cooperative launch failed: %s (grid %d)\n", hipGetErrorString(e), grid);
#endif
}
```

```cpp
#include <hip/hip_runtime.h>
#include <hip/hip_cooperative_groups.h>
#include <cstdio>
#include <cstdint>
namespace cg = cooperative_groups;

#ifndef MK_MULTI
#define MK_MULTI 0
#endif

#define LAS __attribute__((address_space(3)))
typedef unsigned short bf16_t;
typedef short bf16x8 __attribute__((ext_vector_type(8)));
typedef float f32x4 __attribute__((ext_vector_type(4)));
typedef float f32x2 __attribute__((ext_vector_type(2)));
typedef unsigned u32x4 __attribute__((ext_vector_type(4)));
typedef unsigned u32x2 __attribute__((ext_vector_type(2)));

typedef __bf16 bf16x2v __attribute__((ext_vector_type(2)));
__device__ __forceinline__ unsigned cvt_pk_bf16(float lo, float hi) { const f32x2 v = {lo, hi}; return __builtin_bit_cast(unsigned, __builtin_convertvector(v, bf16x2v)); }
__device__ __forceinline__ float bf_lo(unsigned w) { return __uint_as_float(w << 16); }
__device__ __forceinline__ float bf_hi(unsigned w) { return __uint_as_float(w & 0xffff0000u); }
#define LDS_WAIT() asm volatile("s_waitcnt lgkmcnt(0)" ::: "memory")
#define VM_WAIT() asm volatile("s_waitcnt vmcnt(0)" ::: "memory")
__device__ __forceinline__ float wave_sum(float v) {
#pragma unroll
    for (int o = 1; o < 64; o <<= 1) v += __shfl_xor(v, o);
    return v;
}

namespace pg8 {
constexpr int BM = 256, BK = 64, HALF = 128, HTB = HALF * BK * 2, STAGE_BYTES = 8 * HTB, NXCD = 8, WGM = 8;
__host__ __device__ __forceinline__ int lds_byte(int r, int c) { const int st = (r >> 4) * 2 + (c >> 5), rr = r & 15, cc = c & 31, ob = rr * 64 + cc * 2; return st * 1024 + (ob ^ (((ob >> 9) & 1) << 5)); }
__host__ __device__ __forceinline__ void stage_rc(int b, int& R, int& C) { const int st = b / 1024, sb = b % 1024, swz = sb ^ (((sb >> 9) & 1) << 5); R = (st >> 1) * 16 + swz / 64; C = (st & 1) * 32 + (swz % 64) / 2; }
__host__ __device__ __forceinline__ int perm32(int rho) { const int n = rho >> 4, i = rho & 15; return 8 * (i >> 2) + 4 * n + (i & 3); }

struct Unit { int pm, pn; };
struct Gemm { const bf16_t* A; const bf16_t* Bt; int M, N, K; };

struct StaticOrder {
    int nM, nN, nwg, G, c;
    __host__ __device__ void init(int M, int N, int G_, int c_) { nM = M / BM; nN = N / BM; nwg = nM * nN; G = G_; c = c_; }
    __host__ __device__ bool next(int i, Unit& u) const {
        const long L = (long)i * G + c; if (L >= nwg) return false;
        int wgid = (int)L; { const int q = nwg / NXCD, r = nwg % NXCD, xcd = wgid % NXCD, off = wgid / NXCD; wgid = (xcd < r ? xcd * (q + 1) : r * (q + 1) + (xcd - r) * q) + off; }
        const int nig = WGM * nN, gid = wgid / nig, fm = gid * WGM, gsz = (nM - fm) < WGM ? (nM - fm) : WGM;
        u.pm = fm + ((wgid % nig) % gsz); u.pn = (wgid % nig) / gsz; return true;
    }
    __device__ __forceinline__ void a_ready(const Unit&) const {}
    __device__ __forceinline__ void done(const Unit&) const {}
};

template <int MODE> struct EpiB {
    static constexpr bool PERM = true, AFTER_DRAIN = false;
    bf16_t* O; int ldc; const float* bias; const bf16_t* Y; int yld; const float* gain; float* sq;
    __device__ __forceinline__ void operator()(const f32x4 (&acc)[2][2][4][2], const Unit& u, int wr, int wc, int fr, int fq) const {
        const int row0 = u.pm * BM + wr * 64 + fr; const int col0 = u.pn * BM + wc * 32 + 8 * fq;
        f32x4 bv[2][2], gv[2][2];
#pragma unroll
        for (int bj = 0; bj < 2; ++bj)
#pragma unroll
            for (int n = 0; n < 2; ++n) { bv[bj][n] = (MODE == 2) ? *(const f32x4*)(bias + col0 + bj * HALF + 4 * n) : (f32x4){0.f, 0.f, 0.f, 0.f};
                gv[bj][n] = (MODE == 2) ? *(const f32x4*)(gain + col0 + bj * HALF + 4 * n) : (f32x4){1.f, 1.f, 1.f, 1.f}; }
#pragma unroll
        for (int ai = 0; ai < 2; ++ai)
#pragma unroll
            for (int m = 0; m < 4; ++m) { const int grow = row0 + ai * HALF + m * 16; const size_t ro = (size_t)grow * ldc + col0; float rsq = 0.f;
                const float rsc = (MODE == 3) ? sq[grow] : 1.f;
#pragma unroll
                for (int bj = 0; bj < 2; ++bj) { f32x4 v0 = acc[ai][bj][m][0], v1 = acc[ai][bj][m][1];
                    if (MODE == 1) {
#pragma unroll
                        for (int e = 0; e < 4; ++e) { float a = fmaxf(v0[e], 0.f), b = fmaxf(v1[e], 0.f); v0[e] = a * a; v1[e] = b * b; }
                    }
                    if (MODE == 2) { v0 += bv[bj][0]; v1 += bv[bj][1];
                        const u32x4 yw = *(const u32x4*)(Y + (size_t)grow * yld + col0 + bj * HALF);
                        float y[8] = {bf_lo(yw.x), bf_hi(yw.x), bf_lo(yw.y), bf_hi(yw.y), bf_lo(yw.z), bf_hi(yw.z), bf_lo(yw.w), bf_hi(yw.w)};
#pragma unroll
                        for (int e = 0; e < 4; ++e) { v0[e] = y[e] * __builtin_amdgcn_rcpf(1.f + __expf(-v0[e])); v1[e] = y[4 + e] * __builtin_amdgcn_rcpf(1.f + __expf(-v1[e])); }
                    }
                    if (MODE == 2 || MODE == 4) rsq += (v0[0] * v0[0] + v0[1] * v0[1]) + (v0[2] * v0[2] + v0[3] * v0[3]) + (v1[0] * v1[0] + v1[1] * v1[1]) + (v1[2] * v1[2] + v1[3] * v1[3]);
                    if (MODE == 2) { v0 *= gv[bj][0]; v1 *= gv[bj][1]; }
                    if (MODE == 3) { v0 *= rsc; v1 *= rsc; }
                    u32x4 w; w.x = cvt_pk_bf16(v0[0], v0[1]); w.y = cvt_pk_bf16(v0[2], v0[3]); w.z = cvt_pk_bf16(v1[0], v1[1]); w.w = cvt_pk_bf16(v1[2], v1[3]);
                    *(u32x4*)(O + ro + bj * HALF) = w; }
                if (MODE == 2 || (MODE == 4 && (u.pn >> 2) == 1)) { rsq += __shfl_xor(rsq, 16); rsq += __shfl_xor(rsq, 32); if (fq == 0) atomicAdd(sq + grow, rsq); } }
    }
};

template <class Epi, class Sched, bool ALIGN_EPI = false, bool SP2 = false, bool MID = false>
__device__ __forceinline__ void gemm_phase(LAS unsigned char* lds, const Gemm g, const Sched& S, const Epi& E, const float* sqa = nullptr, const float* sqb = nullptr) {
    const int tid = threadIdx.x, wid = __builtin_amdgcn_readfirstlane(tid >> 6), lane = tid & 63, wr = wid >> 2, wc = wid & 3, fr = lane & 15, fq = lane >> 4;
    const int K = g.K, nt = K / BK;
    unsigned voffA[2], voffB[2];
#pragma unroll
    for (int i = 0; i < 2; ++i) { int R, C; stage_rc(tid * 16 + i * 8192, R, C); const int Rb = Epi::PERM ? ((R & ~31) + perm32(R & 31)) : R;
        voffA[i] = (unsigned)(R * K + C) * 2u; voffB[i] = (unsigned)(Rb * K + C) * 2u; }
    const size_t kstep = (size_t)(BK * 2);
    const size_t hstep = (size_t)HALF * K * 2;
    const size_t tstep = 2 * hstep;
    const unsigned ldsw = (unsigned)wid * 1024u;
    const int aoff = lds_byte(wr * 64 + fr, fq * 8), boff = lds_byte(wc * 32 + fr, fq * 8);
#define PG8_SA(b, h) (((b) * 2 + (h)) * HTB)
#define PG8_SB(b, h) ((4 + (b) * 2 + (h)) * HTB)
#define PG8_STAGE(bufoff, gbase, voff) do { _Pragma("unroll") for (int _i = 0; _i < 2; ++_i) \
        __builtin_amdgcn_global_load_lds((const unsigned*)((const char*)(gbase) + (voff)[_i]), (LAS unsigned*)(lds + (bufoff) + ldsw + _i * 8192), 16, 0, 0); } while (0)
#define PG8_LDA(dst, b, h) do { _Pragma("unroll") for (int m = 0; m < 4; ++m) _Pragma("unroll") for (int k = 0; k < 2; ++k) dst[m][k] = *(const LAS bf16x8*)(lds + PG8_SA(b, h) + aoff + m * 2048 + k * 1024); } while (0)
#define PG8_LDB(dst, b, h) do { _Pragma("unroll") for (int n = 0; n < 2; ++n) _Pragma("unroll") for (int k = 0; k < 2; ++k) dst[n][k] = *(const LAS bf16x8*)(lds + PG8_SB(b, h) + boff + n * 2048 + k * 1024); } while (0)
#define PG8_MMA(ai, bj, At, Bt) do { __builtin_amdgcn_s_setprio(1); _Pragma("unroll") for (int m = 0; m < 4; ++m) _Pragma("unroll") for (int n = 0; n < 2; ++n) _Pragma("unroll") for (int k = 0; k < 2; ++k) \
        acc[ai][bj][m][n] = __builtin_amdgcn_mfma_f32_16x16x32_bf16(Bt[n][k], At[m][k], acc[ai][bj][m][n], 0, 0, 0); __builtin_amdgcn_s_setprio(0); } while (0)
#define PG8_WAIT_V(n) asm volatile("s_waitcnt vmcnt(" #n ")" ::: "memory")
#define PG8_WAIT_L(n) asm volatile("s_waitcnt lgkmcnt(" #n ")" ::: "memory")
#define PG8_BAR __builtin_amdgcn_s_barrier()
#define PG8_SCHED __builtin_amdgcn_sched_barrier(0)
    Unit cur, nxt; int ui = 0;
    if (!S.next(0, cur)) return;
    f32x4 acc[2][2][4][2];
#pragma unroll
    for (int a = 0; a < 2; ++a)
#pragma unroll
        for (int b = 0; b < 2; ++b)
#pragma unroll
            for (int m = 0; m < 4; ++m)
#pragma unroll
                for (int n = 0; n < 2; ++n) acc[a][b][m][n] = (f32x4){0.f, 0.f, 0.f, 0.f};
    bf16x8 At[4][2], B0[2][2], B1[2][2];
    const char* cA = (const char*)g.A + (size_t)cur.pm * tstep; const char* cB = (const char*)g.Bt + (size_t)cur.pn * tstep;
    S.a_ready(cur);
    if constexpr (SP2) {
        PG8_STAGE(PG8_SB(0, 0), cB, voffB); PG8_STAGE(PG8_SB(0, 1), cB + hstep, voffB); PG8_STAGE(PG8_SA(0, 0), cA, voffA); PG8_STAGE(PG8_SA(0, 1), cA + hstep, voffA);
        if (wr == 1) PG8_BAR;
        PG8_WAIT_V(2); PG8_BAR;
        PG8_STAGE(PG8_SB(1, 0), cB + kstep, voffB); PG8_STAGE(PG8_SA(1, 0), cA + kstep, voffA); PG8_STAGE(PG8_SB(1, 1), cB + hstep + kstep, voffB);
        PG8_WAIT_V(6); PG8_BAR;
    } else {
        PG8_STAGE(PG8_SB(0, 0), cB, voffB); PG8_STAGE(PG8_SA(0, 0), cA, voffA); PG8_STAGE(PG8_SB(0, 1), cB + hstep, voffB); PG8_STAGE(PG8_SA(0, 1), cA + hstep, voffA);
        if (wr == 1) PG8_BAR;
        PG8_WAIT_V(4); PG8_BAR;
        PG8_STAGE(PG8_SB(1, 0), cB + kstep, voffB); PG8_STAGE(PG8_SA(1, 0), cA + kstep, voffA); PG8_STAGE(PG8_SB(1, 1), cB + hstep + kstep, voffB);
        PG8_WAIT_V(6); PG8_BAR;
    }
    for (;;) {
        const bool has_next = S.next(ui + 1, nxt);
        const char* nA = has_next ? (const char*)g.A + (size_t)nxt.pm * tstep : cA; const char* nB = has_next ? (const char*)g.Bt + (size_t)nxt.pn * tstep : cB;
        for (int t = 0; t < nt; t += 2) {
            const bool last = (t == nt - 2);
            const char* a1 = cA + (size_t)(t + 1) * kstep;
            const char* a2 = last ? nA : cA + (size_t)(t + 2) * kstep; const char* b2 = last ? nB : cB + (size_t)(t + 2) * kstep;
            const char* a3 = a2 + kstep; const char* b3 = b2 + kstep;
            if (last && has_next) S.a_ready(nxt);
            if constexpr (MID) { if (t == (nt >> 1)) {
#pragma unroll
                for (int ai = 0; ai < 2; ++ai)
#pragma unroll
                    for (int m = 0; m < 4; ++m) { const int grow = cur.pm * BM + ai * HALF + wr * 64 + m * 16 + fr;
                        float sc = sqa[grow];
                        asm volatile("s_waitcnt vmcnt(0)" : "+v"(sc) :: "memory");
#pragma unroll
                        for (int bj = 0; bj < 2; ++bj)
#pragma unroll
                            for (int n = 0; n < 2; ++n) acc[ai][bj][m][n] *= sc;
                        asm volatile("" : "+v"(acc[ai][0][m][0]), "+v"(acc[ai][0][m][1]), "+v"(acc[ai][1][m][0]), "+v"(acc[ai][1][m][1]) :: "memory"); } } }
            if constexpr (SP2) {
            PG8_LDB(B0, 0, 0); PG8_LDB(B1, 0, 1); PG8_SCHED; PG8_LDA(At, 0, 0); PG8_STAGE(PG8_SA(1, 1), a1 + hstep, voffA);
            PG8_WAIT_V(8); PG8_WAIT_L(0); PG8_BAR; PG8_MMA(0, 0, At, B0); PG8_MMA(0, 1, At, B1); PG8_BAR; PG8_SCHED;
            PG8_LDA(At, 0, 1); PG8_STAGE(PG8_SB(0, 0), b2, voffB); PG8_STAGE(PG8_SB(0, 1), b2 + hstep, voffB); PG8_STAGE(PG8_SA(0, 0), a2, voffA);
            PG8_WAIT_V(8); PG8_WAIT_L(0); PG8_BAR; PG8_MMA(1, 0, At, B0); PG8_MMA(1, 1, At, B1); PG8_BAR; PG8_SCHED;
            PG8_LDB(B0, 1, 0); PG8_LDB(B1, 1, 1); PG8_SCHED; PG8_LDA(At, 1, 0); PG8_STAGE(PG8_SA(0, 1), a2 + hstep, voffA);
            PG8_WAIT_V(8); PG8_WAIT_L(0); PG8_BAR; PG8_MMA(0, 0, At, B0); PG8_MMA(0, 1, At, B1); PG8_BAR; PG8_SCHED;
            PG8_LDA(At, 1, 1); PG8_STAGE(PG8_SB(1, 0), b3, voffB); PG8_STAGE(PG8_SB(1, 1), b3 + hstep, voffB); PG8_STAGE(PG8_SA(1, 0), a3, voffA);
            PG8_WAIT_V(8); PG8_WAIT_L(0); PG8_BAR; PG8_MMA(1, 0, At, B0); PG8_MMA(1, 1, At, B1); PG8_BAR; PG8_SCHED;
            } else {
            PG8_LDB(B0, 0, 0); PG8_SCHED; PG8_LDA(At, 0, 0); PG8_STAGE(PG8_SA(1, 1), a1 + hstep, voffA);
            PG8_WAIT_L(8); PG8_BAR; PG8_WAIT_L(0); PG8_MMA(0, 0, At, B0); PG8_BAR; PG8_SCHED;
            PG8_LDB(B1, 0, 1); PG8_STAGE(PG8_SB(0, 0), b2, voffB);
            PG8_BAR; PG8_WAIT_L(0); PG8_MMA(0, 1, At, B1); PG8_BAR;
            PG8_LDA(At, 0, 1); PG8_STAGE(PG8_SA(0, 0), a2, voffA);
            PG8_BAR; PG8_WAIT_L(0); PG8_MMA(1, 0, At, B0); PG8_BAR; PG8_SCHED;
            PG8_STAGE(PG8_SB(0, 1), b2 + hstep, voffB);
            PG8_WAIT_V(6); PG8_BAR; PG8_MMA(1, 1, At, B1); PG8_BAR;
            PG8_LDB(B0, 1, 0); PG8_SCHED; PG8_LDA(At, 1, 0); PG8_STAGE(PG8_SA(0, 1), a2 + hstep, voffA);
            PG8_WAIT_L(8); PG8_BAR; PG8_WAIT_L(0); PG8_MMA(0, 0, At, B0); PG8_BAR; PG8_SCHED;
            PG8_LDB(B1, 1, 1); PG8_STAGE(PG8_SB(1, 0), b3, voffB);
            PG8_BAR; PG8_WAIT_L(0); PG8_MMA(0, 1, At, B1); PG8_BAR;
            PG8_LDA(At, 1, 1); PG8_STAGE(PG8_SA(1, 0), a3, voffA);
            PG8_BAR; PG8_WAIT_L(0); PG8_MMA(1, 0, At, B0); PG8_BAR; PG8_SCHED;
            PG8_STAGE(PG8_SB(1, 1), b3 + hstep, voffB);
            PG8_WAIT_V(6); PG8_BAR; PG8_MMA(1, 1, At, B1); PG8_BAR;
            }
        }
        if constexpr (ALIGN_EPI) { if (wr == 0) PG8_BAR; }
        if constexpr (!Epi::AFTER_DRAIN) { E(acc, cur, wr, wc, fr, fq); S.done(cur); }
        if (!has_next) break;
#pragma unroll
        for (int a = 0; a < 2; ++a)
#pragma unroll
            for (int b = 0; b < 2; ++b)
#pragma unroll
                for (int m = 0; m < 4; ++m)
#pragma unroll
                    for (int n = 0; n < 2; ++n) acc[a][b][m][n] = (f32x4){0.f, 0.f, 0.f, 0.f};
        cur = nxt; cA = nA; cB = nB; ++ui;
        if constexpr (ALIGN_EPI) { if (wr == 1) PG8_BAR; }
    }
    PG8_WAIT_V(0);
    if constexpr (!ALIGN_EPI) { if (wr == 0) PG8_BAR; }
    PG8_BAR;
#undef PG8_SA
#undef PG8_SB
#undef PG8_STAGE
#undef PG8_LDA
#undef PG8_LDB
#undef PG8_MMA
#undef PG8_WAIT_V
#undef PG8_WAIT_L
#undef PG8_BAR
#undef PG8_SCHED
}
}

constexpr int NTOK = 16384, NCTX = 8192, DM = 2048, DIN = 3072, DFF = 8192, DCH = 1024;
constexpr int NMODROW = 9, NMOD = 6 * DM;
constexpr float EPS = 1e-6f;
constexpr int NWAVES = 8, NTHR = 512;
constexpr int LDS_BYTES = 147456;
constexpr int NPH = 13;

constexpr size_t MiB = 1u << 20;
constexpr size_t WS_MOD = 0;
constexpr size_t WS_PE = MiB / 2;
constexpr size_t WS_LB = 1 * MiB;
constexpr size_t WS_BB = 2 * MiB;
constexpr size_t WS_CB = 3 * MiB;
constexpr size_t WS_WSB = 7 * MiB;
constexpr size_t WS_CTL = 4 * MiB, CTL_BYTES = 65536;
constexpr size_t WS_SQV = 5 * MiB + 131072;
constexpr size_t WS_SQA = 5 * MiB, WS_SQB = 5 * MiB + 65536;
constexpr size_t WS_RAT = 6 * MiB;
constexpr int LDS_BARW = LDS_BYTES - 64;
constexpr size_t WS_WFF1 = 8 * MiB, WS_WFF2 = 40 * MiB;
constexpr size_t WS_H = 72 * MiB;
constexpr size_t WS_PROJ = 136 * MiB;
constexpr size_t WS_MIX = 136 * MiB;
constexpr size_t WS_HID = 136 * MiB;
constexpr size_t WS_WIN = 242 * MiB, WS_WGLU = 254 * MiB, WS_WOUT = 256 * MiB;
constexpr size_t WS_AO = 264 * MiB;
constexpr size_t WS_F = 264 * MiB;
constexpr size_t WS_YBPRE = 328 * MiB, WS_YB = 328 * MiB;
constexpr size_t WS_X1B = 328 * MiB;
constexpr size_t WS_END = 392 * MiB;

struct Args { const float* in[30]; float* out; unsigned char* ws; int ph_lo, ph_hi; };
enum { I_XP = 0, I_XS, I_ST, I_C, I_CCTX, I_WADA, I_BADA, I_GPREMIX, I_WIN, I_CWS, I_CBS, I_CGV, I_LRE, I_LIM, I_LDT, I_BRE, I_BIM, I_CRE, I_CIM,
       I_SSMD, I_WGLU, I_BGLU, I_GOA, I_GOB, I_WOUT, I_GPOSTMIX, I_GPREFFN, I_WFF1, I_WFF2, I_GPOSTFFN };

struct TItem { const float* src; bf16_t* dst; int K, N; };
__device__ __forceinline__ void titem_load(const TItem& t, f32x4 (&v)[16], int lane) {
#pragma unroll
    for (int i = 0; i < 16; ++i) v[i] = __builtin_nontemporal_load((const f32x4*)(t.src + (size_t)(4 * i + (lane >> 4)) * t.N + 4 * (lane & 15)));
}
__device__ __forceinline__ void titem_store(const TItem& t, const f32x4 (&v)[16], LAS float* scr, int lane) {
#pragma unroll
    for (int i = 0; i < 16; ++i) { LAS float* s = scr + (4 * i + (lane >> 4)) * 65 + 4 * (lane & 15); s[0] = v[i].x; s[1] = v[i].y; s[2] = v[i].z; s[3] = v[i].w; }
    LDS_WAIT();
    const int c = lane & 7;
#pragma unroll
    for (int j = 0; j < 8; ++j) { const int n = (lane >> 3) + 8 * j; const LAS float* s = scr + (8 * c) * 65 + n;
        u32x4 o; o.x = cvt_pk_bf16(s[0 * 65], s[1 * 65]); o.y = cvt_pk_bf16(s[2 * 65], s[3 * 65]); o.z = cvt_pk_bf16(s[4 * 65], s[5 * 65]); o.w = cvt_pk_bf16(s[6 * 65], s[7 * 65]);
        *(u32x4*)(t.dst + (size_t)n * t.K + 8 * c) = o; }
    LDS_WAIT();
}
__device__ __forceinline__ void ssm_lam(const Args& a, int d, int g, int p, float& lbr, float& lbi, float& cfr, float& cfi) {
    const int ix = (d * 64 + g) * 64 + p;
    const float lr = a.in[I_LRE][ix], li = a.in[I_LIM][ix], dt = expf(a.in[I_LDT][d * 64 + g]);
    const float mag = expf(lr * dt); float sn, cs; sincosf(li * dt, &sn, &cs);
    lbr = mag * cs; lbi = mag * sn;
    const float nr = lbr - 1.f, ni = lbi, den = lr * lr + li * li;
    cfr = (nr * lr + ni * li) / den; cfi = (ni * lr - nr * li) / den;
}

__device__ __forceinline__ void p0_prologue(const Args& a, LAS unsigned char* lds, int tid, int lane, int wave, int G, int B) {
    unsigned char* ws = a.ws;
    if (B < 192) {
        LAS float* sl = (LAS float*)lds + wave * (256 * 9);
        LAS float* red = (LAS float*)lds + NWAVES * 256 * 9;
        const int kbase = wave * 256;
        { float xv[9][4];
#pragma unroll
          for (int r = 0; r < 9; ++r)
#pragma unroll
              for (int q = 0; q < 4; ++q) { const int kl = lane + 64 * q; xv[r][q] = (r == 0) ? a.in[I_CCTX][kbase + kl] : a.in[I_C][(r - 1) * DM + kbase + kl]; }
#pragma unroll
          for (int r = 0; r < 9; ++r)
#pragma unroll
              for (int q = 0; q < 4; ++q) { const float x = xv[r][q]; sl[(lane + 64 * q) * 9 + r] = x / (1.f + __expf(-x)); } }
        LDS_WAIT();
        const int kq = lane >> 4, nl = lane & 15, n0 = 64 * B;
        f32x4 acc[9];
#pragma unroll
        for (int r = 0; r < 9; ++r) acc[r] = (f32x4){0.f, 0.f, 0.f, 0.f};
        const float* wp = a.in[I_WADA] + (size_t)(kbase + kq) * NMOD + n0 + 4 * nl;
#pragma unroll 32
        for (int i = 0; i < 64; ++i) { const f32x4 wv = __builtin_nontemporal_load((const f32x4*)(wp + (size_t)(4 * i) * NMOD));
            const LAS float* s = sl + (4 * i + kq) * 9;
#pragma unroll
            for (int r = 0; r < 9; ++r) acc[r] += wv * s[r]; }
#pragma unroll
        for (int r = 0; r < 9; ++r) {
#pragma unroll
            for (int e = 0; e < 4; ++e) { float v = acc[r][e]; v += __shfl_xor(v, 16); v += __shfl_xor(v, 32); acc[r][e] = v; }
            if (kq == 0) *(LAS f32x4*)(red + (wave * 9 + r) * 64 + 4 * nl) = acc[r];
        }
        LDS_WAIT(); __syncthreads();
        for (int e = tid; e < 9 * 64; e += NTHR) { const int r = e >> 6, cidx = e & 63; float s = a.in[I_BADA][n0 + cidx];
#pragma unroll
            for (int w = 0; w < 8; ++w) s += red[(w * 9 + r) * 64 + cidx];
            ((float*)(ws + WS_MOD))[r * NMOD + n0 + cidx] = s; }
        __syncthreads();
    }
    const int gt = B * NTHR + tid, GT = G * NTHR;
    for (int e = gt; e < 2 * 64 * 64; e += GT) { const int d = e >> 12, g = (e >> 6) & 63, p = e & 63; float lbr, lbi, cr, ci; ssm_lam(a, d, g, p, lbr, lbi, cr, ci);
        ((f32x2*)(ws + WS_LB))[e] = (f32x2){lbr, lbi}; }
    for (int e = gt; e < 2 * 64 * 8 * 64; e += GT) {
        const int l = e & 63, nb = (e >> 6) & 7, g = (e >> 9) & 63, d = e >> 15; const int sr = nb * 16 + (l & 15), p = sr >> 1, im = sr & 1, kq = l >> 4;
        u32x4 o = (u32x4){0u, 0u, 0u, 0u};
        if (kq < 2) { float lbr, lbi, cr, ci; ssm_lam(a, d, g, p, lbr, lbi, cr, ci); float v[8];
#pragma unroll
            for (int i = 0; i < 8; ++i) { const int h = kq * 8 + i; const size_t ix = ((size_t)(d * 64 + g) * 64 + p) * 16 + h; const float br = a.in[I_BRE][ix], bi = a.in[I_BIM][ix];
                v[i] = im ? (cr * bi + ci * br) : (cr * br - ci * bi); }
            o.x = cvt_pk_bf16(v[0], v[1]); o.y = cvt_pk_bf16(v[2], v[3]); o.z = cvt_pk_bf16(v[4], v[5]); o.w = cvt_pk_bf16(v[6], v[7]); }
        ((u32x4*)(ws + WS_BB))[e] = o; }
    for (int e = gt; e < 2 * 64 * 4 * 64; e += GT) {
        const int l = e & 63, kb = (e >> 6) & 3, g = (e >> 8) & 63, d = e >> 14; const int ch = l & 15, k0 = kb * 32 + (l >> 4) * 8; float v[8];
#pragma unroll
        for (int i = 0; i < 8; ++i) { const int k = k0 + i; const size_t ix = ((size_t)(d * 64 + g) * 16 + ch) * 64 + (k >> 1); v[i] = (k & 1) ? -a.in[I_CIM][ix] : a.in[I_CRE][ix]; }
        u32x4 o; o.x = cvt_pk_bf16(v[0], v[1]); o.y = cvt_pk_bf16(v[2], v[3]); o.z = cvt_pk_bf16(v[4], v[5]); o.w = cvt_pk_bf16(v[6], v[7]);
        ((u32x4*)(ws + WS_CB))[e] = o; }
    for (int e = gt; e < 3 * NTOK; e += GT) ((float*)(ws + WS_SQA))[e] = 0.f;
    for (int e = gt; e < 8 * 128 * 128 / 8; e += GT) { const f32x4 v0 = *(const f32x4*)(a.in[I_CWS] + 8 * (size_t)e), v1 = *(const f32x4*)(a.in[I_CWS] + 8 * (size_t)e + 4);
        u32x4 o; o.x = cvt_pk_bf16(v0.x, v0.y); o.y = cvt_pk_bf16(v0.z, v0.w); o.z = cvt_pk_bf16(v1.x, v1.y); o.w = cvt_pk_bf16(v1.z, v1.w); *(u32x4*)((bf16_t*)(ws + WS_WSB) + 8 * (size_t)e) = o; }
    for (int e = gt; e < 80 * 1024; e += GT) { const int r = e >> 10, j = e & 1023; const float pos = (float)(r < 16 ? r : r - 16);
        const float fr = 1.0f / powf(10000.0f, (float)(j & 511) / 512.0f); const float ang = pos * fr;
        ((float*)(ws + WS_PE))[e] = (j < 512) ? sinf(ang) : cosf(ang); }
    LAS float* scr = (LAS float*)(lds + wave * 16640);
    constexpr int IT_IN = (DM / 64) * (DIN / 64), IT_GLU = 16 * 16, IT_OUT = 32 * 32, IT_FF1 = (DM / 64) * (DFF / 64), IT_FF2 = (DFF / 64) * (DM / 64);
    constexpr int NITEMS = IT_IN + IT_GLU + IT_OUT + IT_FF1 + IT_FF2;
    static_assert(NITEMS / 8 > 192 * 5 && NITEMS / 8 <= 192 * 5 + 64 * 7, "static transpose split");
    constexpr int NGRP = NITEMS / 8;
    static_assert(NITEMS % 8 == 0 && IT_IN % 8 == 0 && IT_GLU % 8 == 0 && IT_OUT % 8 == 0 && IT_FF1 % 8 == 0, "item groups");
    int it0, nit;
    if (G == 256) { if (B < 192) { nit = 5; it0 = B * 5; } else { it0 = 192 * 5 + (B - 192) * 7; nit = (it0 + 7 <= NGRP) ? 7 : (it0 < NGRP ? NGRP - it0 : 0); } }
    else { const int per = (NGRP + G - 1) / G; it0 = B * per; nit = (it0 + per <= NGRP) ? per : (it0 < NGRP ? NGRP - it0 : 0); }
    auto mk = [&](int grp) { TItem t; int r = grp; const float* W; bf16_t* WT; int K, N;
        if (r < IT_IN / 8) { W = a.in[I_WIN]; WT = (bf16_t*)(ws + WS_WIN); K = DM; N = DIN; }
        else if ((r -= IT_IN / 8) < IT_GLU / 8) { W = a.in[I_WGLU]; WT = (bf16_t*)(ws + WS_WGLU); K = 1024; N = 1024; }
        else if ((r -= IT_GLU / 8) < IT_OUT / 8) { W = a.in[I_WOUT]; WT = (bf16_t*)(ws + WS_WOUT); K = DM; N = DM; }
        else if ((r -= IT_OUT / 8) < IT_FF1 / 8) { W = a.in[I_WFF1]; WT = (bf16_t*)(ws + WS_WFF1); K = DM; N = DFF; }
        else { r -= IT_FF1 / 8; W = a.in[I_WFF2]; WT = (bf16_t*)(ws + WS_WFF2); K = DFF; N = DM; }
        const int ngn = N / 256, k0 = 64 * (2 * (r / ngn) + (wave & 1)), n0 = 64 * (4 * (r % ngn) + (wave >> 1));
        t.src = W + (size_t)k0 * N + n0; t.dst = WT + (size_t)n0 * K + k0; t.K = K; t.N = N; return t; };
    if (nit > 0) {
        TItem cur = mk(it0); f32x4 vc[16]; titem_load(cur, vc, lane);
#pragma unroll 1
        for (int i = 0; i < nit; ++i) {
            f32x4 vn[16]; TItem nx = cur;
            if (i + 1 < nit) { nx = mk(it0 + i + 1); titem_load(nx, vn, lane); }
            titem_store(cur, vc, scr, lane);
            if (i + 1 < nit) {
#pragma unroll
                for (int k = 0; k < 16; ++k) vc[k] = vn[k];
                cur = nx; }
        }
    }
}

__device__ __forceinline__ void load_x_row(const Args& a, int row, int lane, float (&x)[4][8]) {
    const float* xr = (row < NCTX) ? a.in[I_XP] + (size_t)row * DM : a.in[I_XS] + (size_t)(row - NCTX) * DM;
#pragma unroll
    for (int j = 0; j < 4; ++j) { const f32x4 v0 = __builtin_nontemporal_load((const f32x4*)(xr + 8 * lane + 512 * j)), v1 = __builtin_nontemporal_load((const f32x4*)(xr + 8 * lane + 512 * j + 4));
        x[j][0] = v0.x; x[j][1] = v0.y; x[j][2] = v0.z; x[j][3] = v0.w; x[j][4] = v1.x; x[j][5] = v1.y; x[j][6] = v1.z; x[j][7] = v1.w; }
    if (row >= NCTX) { const int t = (row - NCTX) & 1023; const float* pe = (const float*)(a.ws + WS_PE);
#pragma unroll
        for (int j = 0; j < 4; ++j) { const float* pr = (j < 2) ? pe + (size_t)(t >> 6) * 1024 + 8 * lane + 512 * j : pe + (size_t)(16 + (t & 63)) * 1024 + 8 * lane + 512 * (j - 2);
            const f32x4 v0 = *(const f32x4*)pr, v1 = *(const f32x4*)(pr + 4);
            x[j][0] += v0.x; x[j][1] += v0.y; x[j][2] += v0.z; x[j][3] += v0.w; x[j][4] += v1.x; x[j][5] += v1.y; x[j][6] += v1.z; x[j][7] += v1.w; } }
}
__device__ __forceinline__ void load8(const float* p, float (&v)[8]) { const f32x4 a = *(const f32x4*)p, b = *(const f32x4*)(p + 4); v[0] = a.x; v[1] = a.y; v[2] = a.z; v[3] = a.w; v[4] = b.x; v[5] = b.y; v[6] = b.z; v[7] = b.w; }
__device__ __forceinline__ void load8bf(const bf16_t* p, float (&v)[8]) { const u32x4 w = *(const u32x4*)p; v[0] = bf_lo(w.x); v[1] = bf_hi(w.x); v[2] = bf_lo(w.y); v[3] = bf_hi(w.y); v[4] = bf_lo(w.z); v[5] = bf_hi(w.z); v[6] = bf_lo(w.w); v[7] = bf_hi(w.w); }
__device__ __forceinline__ void store8bf(bf16_t* p, const float (&v)[8]) { u32x4 w; w.x = cvt_pk_bf16(v[0], v[1]); w.y = cvt_pk_bf16(v[2], v[3]); w.z = cvt_pk_bf16(v[4], v[5]); w.w = cvt_pk_bf16(v[6], v[7]); *(u32x4*)p = w; }
__device__ __forceinline__ const float* mod_row(const Args& a, int row) { return (const float*)(a.ws + WS_MOD) + (size_t)((row < NCTX) ? 0 : 1 + ((row - NCTX) >> 10)) * NMOD; }

__device__ __forceinline__ void r1_rows(const Args& a, int gw, int NGW, int lane) {
    bf16_t* H = (bf16_t*)(a.ws + WS_H);
    for (int row0 = 2 * gw; row0 < NTOK; row0 += 2 * NGW) {
        const int rowv[2] = {row0, row0 + 1};
        float x[2][4][8];
#pragma unroll
        for (int u = 0; u < 2; ++u) load_x_row(a, rowv[u], lane, x[u]);
        const float* md = mod_row(a, row0);
        float rstd[2];
#pragma unroll
        for (int u = 0; u < 2; ++u) { float s = 0.f;
#pragma unroll
            for (int j = 0; j < 4; ++j)
#pragma unroll
                for (int e = 0; e < 8; ++e) s += x[u][j][e] * x[u][j][e];
            rstd[u] = rsqrtf(wave_sum(s) * (1.f / DM) + EPS); }
#pragma unroll
        for (int j = 0; j < 4; ++j) { const int c = 8 * lane + 512 * j; float g[8], sh[8], sc[8]; load8(a.in[I_GPREMIX] + c, g); load8(md + c, sh); load8(md + DM + c, sc);
#pragma unroll
            for (int u = 0; u < 2; ++u) { float o[8];
#pragma unroll
                for (int e = 0; e < 8; ++e) o[e] = x[u][j][e] * rstd[u] * g[e] * (1.f + sc[e]) + sh[e];
                store8bf(H + (size_t)rowv[u] * DM + c, o); } }
    }
}
__device__ __forceinline__ void r2_rows(const Args& a, int gw, int NGW, int lane) {
    const bf16_t* Yb = (const bf16_t*)(a.ws + WS_YB); bf16_t* AO = (bf16_t*)(a.ws + WS_AO);
    for (int row0 = gw; row0 < NTOK; row0 += 4 * NGW) {
        int rowv[4]; float y[4][2][8];
#pragma unroll
        for (int u = 0; u < 4; ++u) { rowv[u] = (row0 + u * NGW < NTOK) ? row0 + u * NGW : row0;
#pragma unroll
            for (int j = 0; j < 2; ++j) load8bf(Yb + (size_t)rowv[u] * DCH + 8 * lane + 512 * j, y[u][j]); }
#pragma unroll
        for (int u = 0; u < 4; ++u) { const int row = rowv[u]; float s = 0.f;
#pragma unroll
            for (int j = 0; j < 2; ++j)
#pragma unroll
                for (int e = 0; e < 8; ++e) s += y[u][j][e] * y[u][j][e];
            const float rstd = rsqrtf(wave_sum(s) * (1.f / DCH) + EPS);
#pragma unroll
            for (int j = 0; j < 2; ++j) { const int c = 8 * lane + 512 * j; float g[8], o[8]; load8(a.in[I_GOB] + c, g);
#pragma unroll
                for (int e = 0; e < 8; ++e) o[e] = y[u][j][e] * rstd * g[e];
                store8bf(AO + (size_t)row * DM + DCH + c, o); } }
    }
}
__device__ __forceinline__ void r3_rows(const Args& a, int gw, int NGW, int lane) {
    const bf16_t* MX = (const bf16_t*)(a.ws + WS_MIX); bf16_t* H = (bf16_t*)(a.ws + WS_H);
    for (int row0 = 2 * gw; row0 < NTOK; row0 += 2 * NGW) {
        const int rowv[2] = {row0, row0 + 1};
        float x[2][4][8], m[2][4][8];
#pragma unroll
        for (int u = 0; u < 2; ++u) { load_x_row(a, rowv[u], lane, x[u]);
#pragma unroll
            for (int j = 0; j < 4; ++j) load8bf(MX + (size_t)rowv[u] * DM + 8 * lane + 512 * j, m[u][j]); }
        const float* md = mod_row(a, row0);
        float rstd[2], s2[2] = {0.f, 0.f};
#pragma unroll
        for (int u = 0; u < 2; ++u) { float s = 0.f;
#pragma unroll
            for (int j = 0; j < 4; ++j)
#pragma unroll
                for (int e = 0; e < 8; ++e) s += m[u][j][e] * m[u][j][e];
            rstd[u] = rsqrtf(wave_sum(s) * (1.f / DM) + EPS); }
#pragma unroll
        for (int j = 0; j < 4; ++j) { const int c = 8 * lane + 512 * j; float g[8], gt[8]; load8(a.in[I_GPOSTMIX] + c, g); load8(md + 2 * DM + c, gt);
#pragma unroll
            for (int u = 0; u < 2; ++u) {
#pragma unroll
                for (int e = 0; e < 8; ++e) { x[u][j][e] += gt[e] * (m[u][j][e] * rstd[u] * g[e]); s2[u] += x[u][j][e] * x[u][j][e]; }
                store8bf((bf16_t*)(a.ws + WS_X1B) + (size_t)rowv[u] * DM + c, x[u][j]); } }
        float rstd2[2];
#pragma unroll
        for (int u = 0; u < 2; ++u) rstd2[u] = rsqrtf(wave_sum(s2[u]) * (1.f / DM) + EPS);
#pragma unroll
        for (int j = 0; j < 4; ++j) { const int c = 8 * lane + 512 * j; float g[8], sh[8], sc[8]; load8(a.in[I_GPREFFN] + c, g); load8(md + 3 * DM + c, sh); load8(md + 4 * DM + c, sc);
#pragma unroll
            for (int u = 0; u < 2; ++u) { float o[8];
#pragma unroll
                for (int e = 0; e < 8; ++e) o[e] = x[u][j][e] * rstd2[u] * g[e] * (1.f + sc[e]) + sh[e];
                store8bf(H + (size_t)rowv[u] * DM + c, o); } }
    }
}
__device__ __forceinline__ void r4_rows(const Args& a, int gw, int NGW, int lane) {
    const bf16_t* F = (const bf16_t*)(a.ws + WS_F);
    for (int row0 = 2 * gw; row0 < NTOK; row0 += 2 * NGW) {
        const int rowv[2] = {row0, row0 + 1};
        float f[2][4][8], x1[2][4][8];
#pragma unroll
        for (int u = 0; u < 2; ++u)
#pragma unroll
            for (int j = 0; j < 4; ++j) { load8bf(F + (size_t)rowv[u] * DM + 8 * lane + 512 * j, f[u][j]); load8bf((const bf16_t*)(a.ws + WS_X1B) + (size_t)rowv[u] * DM + 8 * lane + 512 * j, x1[u][j]); }
        const float* md = mod_row(a, row0);
        float rstd[2];
#pragma unroll
        for (int u = 0; u < 2; ++u) { float s = 0.f;
#pragma unroll
            for (int j = 0; j < 4; ++j)
#pragma unroll
                for (int e = 0; e < 8; ++e) s += f[u][j][e] * f[u][j][e];
            rstd[u] = rsqrtf(wave_sum(s) * (1.f / DM) + EPS); }
#pragma unroll
        for (int j = 0; j < 4; ++j) { const int c = 8 * lane + 512 * j; float g[8], gt[8]; load8(a.in[I_GPOSTFFN] + c, g); load8(md + 5 * DM + c, gt);
#pragma unroll
            for (int u = 0; u < 2; ++u) { float* o = a.out + (size_t)rowv[u] * DM + c;
#pragma unroll
                for (int e = 0; e < 8; ++e) x1[u][j][e] += gt[e] * (f[u][j][e] * rstd[u] * g[e]);
                __builtin_nontemporal_store((f32x4){x1[u][j][0], x1[u][j][1], x1[u][j][2], x1[u][j][3]}, (f32x4*)o); __builtin_nontemporal_store((f32x4){x1[u][j][4], x1[u][j][5], x1[u][j][6], x1[u][j][7]}, (f32x4*)(o + 4)); } }
    }
}

__device__ __forceinline__ float gelu_tanh(float v) { const float u = 1.5957691216f * (v + 0.044715f * v * v * v); return v * __builtin_amdgcn_rcpf(1.f + __expf(-u)); }

template <int DIR, int MODE>
__device__ __forceinline__ void ssm_task(const Args& a, LAS unsigned char* wl, LAS unsigned char* yl, int b, int g, int lane) {
    constexpr bool lat = (MODE == 0);
    const int L = lat ? 1024 : 256; const int rowbase = lat ? NCTX + b * 1024 : b * 256;
    LAS float* S = (LAS float*)wl;
    LAS bf16_t* Hs = (LAS bf16_t*)(wl + 16 * 132 * 4);
    bf16x8 bb[8], cb[4];
    { const bf16x8* p = (const bf16x8*)(a.ws + WS_BB) + (size_t)((DIR * 64 + g) * 8) * 64 + lane;
#pragma unroll
      for (int nb = 0; nb < 8; ++nb) bb[nb] = p[nb * 64]; }
    { const bf16x8* p = (const bf16x8*)(a.ws + WS_CB) + (size_t)((DIR * 64 + g) * 4) * 64 + lane;
#pragma unroll
      for (int kb = 0; kb < 4; ++kb) cb[kb] = p[kb * 64]; }
    const f32x2 lam = ((const f32x2*)(a.ws + WS_LB))[(DIR * 64 + g) * 64 + lane];
    f32x2 h = (f32x2){0.f, 0.f};
    if (lat) { const float* st = a.in[I_ST] + (size_t)((b * 2 + DIR) * 2) * 4096 + g * 64 + lane; h.x = st[0]; h.y = st[4096]; }
    const f32x2 lamx = (f32x2){lam.x, lam.x}, lamy = (f32x2){-lam.y, lam.y};
    const bf16_t* ub = (const bf16_t*)(a.ws + WS_PROJ) + (size_t)rowbase * DIN + 2048 + g * 16 + ((lane >> 4) & 1) * 8;
    float* yp = a.out + (size_t)DIR * NTOK * DCH + (size_t)rowbase * DCH + g * 16 + (lane >> 4) * 4;
    const int nt = L / 16;
#define SSM_T0(i_) ((DIR ? nt - 1 - (i_) : (i_)) * 16)
    const bf16_t* uwb = (const bf16_t*)(a.ws + WS_PROJ) + (size_t)rowbase * DIN + 2048 + g * 16 + (lane >> 4) * 4;
    const f32x4 dsk = *(const f32x4*)(a.in[I_SSMD] + g * 16 + (lane >> 4) * 4);
    auto load_u = [&](const int i_) __attribute__((always_inline)) { return *(const bf16x8*)(ub + (size_t)(SSM_T0(i_) + (lane & 15)) * DIN); };
    auto load_uw = [&](const int i_) __attribute__((always_inline)) { return *(const u32x2*)(uwb + (size_t)(SSM_T0(i_) + (lane & 15)) * DIN); };
    auto stage_bu = [&](const bf16x8 uf) __attribute__((always_inline)) {
#pragma unroll
        for (int nb = 0; nb < 8; ++nb) { const f32x4 acc = __builtin_amdgcn_mfma_f32_16x16x32_bf16(bb[nb], uf, (f32x4){0.f, 0.f, 0.f, 0.f}, 0, 0, 0);
            u32x2 o; o.x = cvt_pk_bf16(acc[0], acc[1]); o.y = cvt_pk_bf16(acc[2], acc[3]);
            *(LAS u32x2*)((LAS unsigned*)S + (lane & 15) * 68 + nb * 8 + (lane >> 4) * 2) = o; } };
    auto read_bu = [&](f32x2 (&bu)[16]) __attribute__((always_inline)) {
#pragma unroll
        for (int s = 0; s < 16; ++s) { const unsigned w = ((const LAS unsigned*)S)[(DIR ? 15 - s : s) * 68 + lane]; bu[s] = (f32x2){bf_lo(w), bf_hi(w)}; } };
    auto scan = [&](const f32x2 (&bu)[16]) __attribute__((always_inline)) {
#pragma unroll
        for (int s = 0; s < 16; ++s) { const int tt = DIR ? 15 - s : s;
            const f32x2 t1 = lamx * h + bu[s]; h = lamy * __builtin_shufflevector(h, h, 1, 0) + t1;
            ((LAS unsigned*)Hs)[tt * 68 + lane] = cvt_pk_bf16(h.x, h.y); } };
    auto emit_y = [&](const int i_, const u32x2 uw) __attribute__((always_inline)) {
        const int t0 = SSM_T0(i_);
        f32x4 y = (f32x4){0.f, 0.f, 0.f, 0.f};
#pragma unroll
        for (int kb = 0; kb < 4; ++kb) { const bf16x8 hf = __builtin_bit_cast(bf16x8, *(const LAS u32x4*)(Hs + (lane & 15) * 136 + kb * 32 + (lane >> 4) * 8));
            y = __builtin_amdgcn_mfma_f32_16x16x32_bf16(cb[kb], hf, y, 0, 0, 0); }
        if constexpr (MODE == 0) *(f32x4*)(yp + (size_t)(t0 + (lane & 15)) * DCH) = y;
        if constexpr (MODE == 1) { u32x2 o; o.x = cvt_pk_bf16(y[0], y[1]); o.y = cvt_pk_bf16(y[2], y[3]); *(LAS u32x2*)(yl + (t0 + (lane & 15)) * 32 + (lane >> 4) * 8) = o; }
        if constexpr (MODE == 2) { const u32x2 yw = *(const LAS u32x2*)(yl + (t0 + (lane & 15)) * 32 + (lane >> 4) * 8);
            const size_t row = (size_t)(rowbase + t0 + (lane & 15)); const int ch = g * 16 + (lane >> 4) * 4; const f32x4 d = dsk;
            const float v0 = gelu_tanh(bf_lo(yw.x) + y[0] + d.x * bf_lo(uw.x)), v1 = gelu_tanh(bf_hi(yw.x) + y[1] + d.y * bf_hi(uw.x)), v2 = gelu_tanh(bf_lo(yw.y) + y[2] + d.z * bf_lo(uw.y)), v3 = gelu_tanh(bf_hi(yw.y) + y[3] + d.w * bf_hi(uw.y));
            u32x2 o; o.x = cvt_pk_bf16(v0, v1); o.y = cvt_pk_bf16(v2, v3); *(u32x2*)((bf16_t*)(a.ws + WS_YBPRE) + row * DCH + ch) = o; } };
    bf16x8 un = load_u(0);
    u32x2 uwc = (u32x2){0u, 0u}, uwn = (u32x2){0u, 0u};
    if (MODE == 2) uwn = load_uw(0);
    stage_bu(un);
    un = load_u(1);
    { f32x2 bu[16]; read_bu(bu); const bf16x8 uf = un; un = load_u(2); stage_bu(uf); scan(bu); uwc = uwn; if (MODE == 2) uwn = load_uw(1); }
#pragma unroll 1
    for (int i = 1; i < nt - 1; ++i) {
        f32x2 bu[16]; read_bu(bu);
        const bf16x8 uf = un; un = load_u((i + 2 < nt) ? i + 2 : nt - 1);
        stage_bu(uf);
        emit_y(i - 1, uwc);
        scan(bu);
        uwc = uwn; if (MODE == 2) uwn = load_uw(i + 1);
    }
    { f32x2 bu[16]; read_bu(bu); emit_y(nt - 2, uwc); scan(bu); uwc = uwn; }
    emit_y(nt - 1, uwc);
#undef SSM_T0
    if (!lat) { float* o = a.out + (size_t)NTOK * DM + (size_t)((b * 2 + DIR) * 2) * 4096 + g * 64 + lane; o[0] = h.x; o[4096] = h.y; }
}

__device__ __forceinline__ void ssm_phase(const Args& a, LAS unsigned char* lds, int tid, int lane, int wave, int B) {
    LAS unsigned char* wl = lds + wave * 12800;
    LAS unsigned char* yl = lds + NWAVES * 12800 + (wave & 3) * 8192;
    volatile LAS unsigned* pflag = (volatile LAS unsigned*)(lds + NWAVES * 12800 + 4 * 8192);
    if (tid < 2) pflag[tid] = 0u;
    LDS_WAIT(); __syncthreads();
    if (wave < 4) { const int pl = wave >> 1, pair = 2 * B + pl; const int b = pair >> 6, g = pair & 63;
        if (wave & 1) ssm_task<1, 0>(a, wl, yl, b, g, lane); else ssm_task<0, 0>(a, wl, yl, b, g, lane);
        VM_WAIT();
        if (lane == 0) __hip_atomic_fetch_add((LAS unsigned*)(pflag + pl), 1u, __ATOMIC_RELAXED, __HIP_MEMORY_SCOPE_WORKGROUP);
        { unsigned spins = 0; while (pflag[pl] < 2u && ++spins < (1u << 22)) __builtin_amdgcn_s_sleep(4); }
        asm volatile("" ::: "memory");
        const float* y0 = a.out; const float* y1 = a.out + (size_t)NTOK * DCH;
        const bf16_t* proj = (const bf16_t*)(a.ws + WS_PROJ); bf16_t* YP = (bf16_t*)(a.ws + WS_YBPRE);
        const int rowbase = NCTX + b * 1024 + (wave & 1) * 512, ch = g * 16 + 4 * (lane & 3);
        const f32x4 d = *(const f32x4*)(a.in[I_SSMD] + ch);
#pragma unroll 8
        for (int it = 0; it < 32; ++it) { const int row = rowbase + it * 16 + (lane >> 2);
            const f32x4 yf = *(const f32x4*)(y0 + (size_t)row * DCH + ch), yb = *(const f32x4*)(y1 + (size_t)row * DCH + ch);
            const u32x2 uw = *(const u32x2*)(proj + (size_t)row * DIN + 2048 + ch);
            const float v0 = gelu_tanh(yf.x + yb.x + d.x * bf_lo(uw.x)), v1 = gelu_tanh(yf.y + yb.y + d.y * bf_hi(uw.x)), v2 = gelu_tanh(yf.z + yb.z + d.z * bf_lo(uw.y)), v3 = gelu_tanh(yf.w + yb.w + d.w * bf_hi(uw.y));
            u32x2 o; o.x = cvt_pk_bf16(v0, v1); o.y = cvt_pk_bf16(v2, v3); *(u32x2*)(YP + (size_t)row * DCH + ch) = o; }
    } else {
#pragma unroll 1
        for (int q = 0; q < 2; ++q) { const int pair = 8 * B + 2 * (wave - 4) + q; const int b = pair >> 6, g = pair & 63;
            ssm_task<0, 1>(a, wl, yl, b, g, lane); ssm_task<1, 2>(a, wl, yl, b, g, lane); }
    }
    VM_WAIT(); __syncthreads();
}

__device__ __forceinline__ void chunk_unit(const Args& a, LAS unsigned char* lds, int tid, int lane, int wave, int unit) {
    LAS bf16_t* Ws = (LAS bf16_t*)lds;
    LAS bf16_t* Vt = (LAS bf16_t*)(lds + 128 * 136 * 2);
    LAS float* rstdv = (LAS float*)(lds + 2 * 128 * 136 * 2);
    const bf16_t* proj = (const bf16_t*)(a.ws + WS_PROJ); bf16_t* AO = (bf16_t*)(a.ws + WS_AO);
    const int r0 = (unit >> 1) * 128, h0 = (unit & 1) * 4;
    if (tid < 128) rstdv[tid] = rsqrtf(((const float*)(a.ws + WS_SQV))[r0 + tid] * (1.f / DCH) + EPS);
    const int wr = wave >> 2, wc = wave & 3, fr = lane & 15, fq = lane >> 4;
    float rs[4] = {0.f, 0.f, 0.f, 0.f};
    u32x4 wreg[4]; u32x4 vreg[4];
#define CH_LOAD(h) do { const bf16_t* wsrc = (const bf16_t*)(a.ws + WS_WSB) + (size_t)(h) * 16384; \
        _Pragma("unroll") for (int i = 0; i < 4; ++i) { const int idx = tid + NTHR * i; wreg[i] = *(const u32x4*)(wsrc + (idx >> 4) * 128 + 8 * (idx & 15)); } \
        _Pragma("unroll") for (int i = 0; i < 4; ++i) { const int c = tid + NTHR * i; vreg[i] = *(const u32x4*)(proj + (size_t)(r0 + (c & 127)) * DIN + 1024 + (h) * 128 + 8 * (c >> 7)); } } while (0)
    CH_LOAD(h0);
    LDS_WAIT(); __syncthreads();
#pragma unroll 1
    for (int hh = 0; hh < 4; ++hh) { const int h = h0 + hh;
#pragma unroll
        for (int i = 0; i < 4; ++i) { const int idx = tid + NTHR * i, p = idx >> 4, q8 = idx & 15; *(LAS u32x4*)(Ws + p * 136 + 8 * q8) = wreg[i]; }
#pragma unroll
        for (int i = 0; i < 4; ++i) { const int c = tid + NTHR * i, q = c & 127, d8 = c >> 7; float g[8]; const u32x4 w = vreg[i];
            const float v[8] = {bf_lo(w.x), bf_hi(w.x), bf_lo(w.y), bf_hi(w.y), bf_lo(w.z), bf_hi(w.z), bf_lo(w.w), bf_hi(w.w)};
            load8(a.in[I_CGV] + h * 128 + 8 * d8, g); const float rv = rstdv[q];
#pragma unroll
            for (int e = 0; e < 8; e += 2) { const unsigned pk = cvt_pk_bf16(v[e] * rv * g[e], v[e + 1] * rv * g[e + 1]);
                Vt[(8 * d8 + e) * 136 + q] = (bf16_t)(pk & 0xffffu); Vt[(8 * d8 + e + 1) * 136 + q] = (bf16_t)(pk >> 16); } }
        u32x2 uwv[4][2];
#pragma unroll
        for (int m = 0; m < 4; ++m)
#pragma unroll
            for (int n = 0; n < 2; ++n) uwv[m][n] = *(const u32x2*)(proj + (size_t)(r0 + 64 * wr + 16 * m + fr) * DIN + h * 128 + 32 * wc + 16 * n + 4 * fq);
        if (hh + 1 < 4) CH_LOAD(h + 1);
        LDS_WAIT(); __syncthreads();
        f32x4 acc[4][2];
#pragma unroll
        for (int m = 0; m < 4; ++m)
#pragma unroll
            for (int n = 0; n < 2; ++n) acc[m][n] = (f32x4){0.f, 0.f, 0.f, 0.f};
#pragma unroll
        for (int ks = 0; ks < 4; ++ks) { bf16x8 af[4], bfr[2];
#pragma unroll
            for (int m = 0; m < 4; ++m) af[m] = *(const LAS bf16x8*)(Ws + (64 * wr + 16 * m + fr) * 136 + ks * 32 + fq * 8);
#pragma unroll
            for (int n = 0; n < 2; ++n) bfr[n] = *(const LAS bf16x8*)(Vt + (32 * wc + 16 * n + fr) * 136 + ks * 32 + fq * 8);
#pragma unroll
            for (int m = 0; m < 4; ++m)
#pragma unroll
                for (int n = 0; n < 2; ++n) acc[m][n] = __builtin_amdgcn_mfma_f32_16x16x32_bf16(bfr[n], af[m], acc[m][n], 0, 0, 0); }
#pragma unroll
        for (int m = 0; m < 4; ++m) { const int p = 64 * wr + 16 * m + fr; const float bs = a.in[I_CBS][h * 128 + p];
#pragma unroll
            for (int n = 0; n < 2; ++n) { const int d = 32 * wc + 16 * n + 4 * fq; const u32x2 uw = uwv[m][n]; const f32x4 g4 = *(const f32x4*)(a.in[I_GOA] + h * 128 + d);
                const float y0 = bf_lo(uw.x) * (acc[m][n][0] + bs), y1 = bf_hi(uw.x) * (acc[m][n][1] + bs), y2 = bf_lo(uw.y) * (acc[m][n][2] + bs), y3 = bf_hi(uw.y) * (acc[m][n][3] + bs);
                rs[m] += (y0 * y0 + y1 * y1) + (y2 * y2 + y3 * y3);
                u32x2 o; o.x = cvt_pk_bf16(y0 * g4.x, y1 * g4.y); o.y = cvt_pk_bf16(y2 * g4.z, y3 * g4.w); *(u32x2*)(AO + (size_t)(r0 + p) * DM + h * 128 + d) = o; } }
        __syncthreads();
    }
#undef CH_LOAD
    float* sqa = (float*)(a.ws + WS_SQA);
#pragma unroll
    for (int m = 0; m < 4; ++m) { float s = rs[m]; s += __shfl_xor(s, 16); s += __shfl_xor(s, 32); if (fq == 0) atomicAdd(sqa + r0 + 64 * wr + 16 * m + fr, s); }
}

#define XB_TMO      128
#define XB_XCNT(j)  (256  + 64 * (j))
#define XB_XSUB(j)  (1280 + 64 * (j))
#define XB_XGEN(j)  (2304 + 64 * (j))
#define XB_TOP      3328
#define XB_TOPGEN   3392
#define XCD_BAR_WORDS 3456
#define XB_SPIN_CAP (1u << 22)
__device__ __forceinline__ unsigned xb_ld(unsigned* p)              { return __hip_atomic_load(p, __ATOMIC_RELAXED, __HIP_MEMORY_SCOPE_AGENT); }
__device__ __forceinline__ unsigned xb_add(unsigned* p, unsigned v) { return __hip_atomic_fetch_add(p, v, __ATOMIC_RELAXED, __HIP_MEMORY_SCOPE_AGENT); }
__device__ __forceinline__ unsigned xb_xcc_id() { return (unsigned)__builtin_amdgcn_s_getreg((3 << 11) | 20) & 0xFu; }
#define XB_SPIN(cond, bar) do { unsigned _sp = 0; while (cond) { __builtin_amdgcn_s_sleep(1); \
    if ((++_sp & 255u) == 0u) { if (xb_ld(&(bar)[XB_TMO])) break; if (_sp > XB_SPIN_CAP) { atomicAdd(&(bar)[XB_TMO], 1u); break; } } } } while (0)
struct XcdBarrier { unsigned* bar; unsigned x; volatile LAS unsigned* st; };
__device__ __forceinline__ XcdBarrier xcd_barrier_post(unsigned* bar, volatile LAS unsigned* st) {
    XcdBarrier b; b.bar = bar; b.x = xb_xcc_id(); b.st = st;
    if (threadIdx.x == 0) (void)xb_add(&bar[XB_XCNT(b.x)], 1u);
    return b;
}
__device__ __forceinline__ void xcd_barrier_complete(unsigned* bar, unsigned x, unsigned& nloc, unsigned& nx) {
    const unsigned G = gridDim.x * gridDim.y * gridDim.z;
    unsigned sum, cnt, mine, sp = 0u;
    for (;;) {
        sum = 0u; cnt = 0u; mine = 0u;
#pragma unroll
        for (unsigned j = 0; j < 16; ++j) { const unsigned c = xb_ld(&bar[XB_XCNT(j)]); sum += c; cnt += (c > 0u) ? 1u : 0u; mine = (j == x) ? c : mine; }
        if (sum == G) break;
        __builtin_amdgcn_s_sleep(1);
        if ((++sp & 255u) == 0u) { if (xb_ld(&bar[XB_TMO])) break; if (sp > XB_SPIN_CAP) { atomicAdd(&bar[XB_TMO], 1u); break; } }
    }
    nloc = mine > 0u ? mine : 1u; nx = cnt > 0u ? cnt : 1u;
}
__device__ __forceinline__ void xcd_barrier(const XcdBarrier& b) {
    asm volatile("s_waitcnt vmcnt(0)" ::: "memory");
    __syncthreads();
    if (threadIdx.x == 0) {
        unsigned* bar = b.bar;
        __builtin_amdgcn_s_waitcnt(0);
        unsigned nloc = b.st[0], nx = b.st[1];
        if (nloc == 0u) { xcd_barrier_complete(bar, b.x, nloc, nx); b.st[0] = nloc; b.st[1] = nx; }
        const unsigned old = xb_add(&bar[XB_XSUB(b.x)], 1u);
        const unsigned gen = old / nloc;
        if (old + 1u == (gen + 1u) * nloc) {
            __builtin_amdgcn_fence(__ATOMIC_RELEASE, "agent");
            asm volatile("s_waitcnt vmcnt(0)" ::: "memory");
            const unsigned og = xb_add(&bar[XB_TOP], 1u);
            const unsigned tg = og / nx;
            if (og + 1u == (tg + 1u) * nx) xb_add(&bar[XB_TOPGEN], 1u);
            else XB_SPIN(xb_ld(&bar[XB_TOPGEN]) == tg, bar);
            __builtin_amdgcn_fence(__ATOMIC_ACQUIRE, "agent");
            xb_add(&bar[XB_XGEN(b.x)], 1u);
            asm volatile("s_waitcnt vmcnt(0)" ::: "memory");
        } else {
            XB_SPIN(xb_ld(&bar[XB_XGEN(b.x)]) == gen, bar);
            __builtin_amdgcn_fence(__ATOMIC_ACQUIRE, "agent");
            asm volatile("s_waitcnt vmcnt(0)" ::: "memory");
        }
    }
    __syncthreads();
}

__global__ void __launch_bounds__(NTHR, 2) fwd_kernel(Args a) {
    extern __shared__ __attribute__((aligned(16))) unsigned char lds_raw[];
    LAS unsigned char* lds = (LAS unsigned char*)lds_raw;
    const int tid = threadIdx.x, lane = tid & 63, wave = __builtin_amdgcn_readfirstlane(tid >> 6);
    const int G = gridDim.x, B = blockIdx.x;
    const int gw = B * NWAVES + wave, NGW = G * NWAVES;
    const int lo = a.ph_lo, hi = a.ph_hi;
    unsigned char* ws = a.ws;
#ifndef PH_MASK
#define PH_MASK 0xFFFF
#endif
#define IN(k) (((PH_MASK >> (k)) & 1) && lo <= (k) && (k) < hi)
    volatile LAS unsigned* bst = (volatile LAS unsigned*)(lds + LDS_BARW);
    if (tid == 0) { bst[0] = 0u; bst[1] = 0u; }
    __syncthreads();
    XcdBarrier xbar = xcd_barrier_post((unsigned*)(ws + WS_CTL), bst);
#define SEAM(k) do { if (IN(k) && IN((k) + 1)) { xcd_barrier(xbar); } } while (0)
#ifndef REP_MASK
#define REP_MASK 0
#endif
#define REP(k) (((REP_MASK >> (k)) & 1) ? 2 : 1)
#define RSYNC(k, r) do { if (r + 1 < REP(k)) xcd_barrier(xbar); } while (0)

    if (IN(0)) { for (int r = 0; r < REP(0); ++r) { p0_prologue(a, lds, tid, lane, wave, G, B); RSYNC(0, r); } } SEAM(0);
    if (IN(1)) { for (int r = 0; r < REP(1); ++r) { r1_rows(a, gw, NGW, lane); RSYNC(1, r); } } SEAM(1);
    if (IN(2)) { pg8::Gemm g{(const bf16_t*)(ws + WS_H), (const bf16_t*)(ws + WS_WIN), NTOK, DIN, DM}; pg8::StaticOrder S; S.init(NTOK, DIN, G, B);
        pg8::EpiB<4> E{(bf16_t*)(ws + WS_PROJ), DIN, nullptr, nullptr, 0, nullptr, (float*)(ws + WS_SQV)};
        pg8::gemm_phase<pg8::EpiB<4>, pg8::StaticOrder, true, true>(lds, g, S, E); } SEAM(2);
    #ifndef REP_SSM
#define REP_SSM 1
#endif
#ifndef REP_CH
#define REP_CH 1
#endif
    if (IN(3)) {
#pragma unroll 1
        for (int r = 0; r < REP_SSM; ++r) ssm_phase(a, lds, tid, lane, wave, B);
#pragma unroll 1
        for (int r = 0; r < REP_CH; ++r) for (int u = B; u < 256; u += G) chunk_unit(a, lds, tid, lane, wave, u);
    } SEAM(3);
    if (IN(4)) { pg8::Gemm g{(const bf16_t*)(ws + WS_YBPRE), (const bf16_t*)(ws + WS_WGLU), NTOK, DCH, DCH}; pg8::StaticOrder S; S.init(NTOK, DCH, G, B);
        pg8::EpiB<2> E{(bf16_t*)(ws + WS_AO) + DCH, DM, a.in[I_BGLU], (const bf16_t*)(ws + WS_YBPRE), DCH, a.in[I_GOB], (float*)(ws + WS_SQB)};
        for (int r = 0; r < REP(4); ++r) { pg8::gemm_phase<pg8::EpiB<2>, pg8::StaticOrder, false, true>(lds, g, S, E); RSYNC(4, r); } } SEAM(4);
    if (IN(6)) { pg8::Gemm g{(const bf16_t*)(ws + WS_AO), (const bf16_t*)(ws + WS_WOUT), NTOK, DM, DM}; pg8::StaticOrder S; S.init(NTOK, DM, G, B);
        { float* sqa = (float*)(ws + WS_SQA); float* sqb = (float*)(ws + WS_SQB); float* rat = (float*)(ws + WS_RAT); float* rbv = rat + NTOK; pg8::Unit u;
          for (int i = 0; S.next(i, u); ++i) if (tid < 256) { const int row = u.pm * 256 + tid; const float ra = rsqrtf(sqa[row] * (1.f / 1024.f) + EPS), rb = rsqrtf(sqb[row] * (1.f / 1024.f) + EPS); rat[row] = ra / rb; rbv[row] = rb; }
          VM_WAIT(); __syncthreads(); }
        pg8::EpiB<3> E{(bf16_t*)(ws + WS_MIX), DM, nullptr, nullptr, 0, nullptr, (float*)(ws + WS_RAT) + NTOK};
        for (int r = 0; r < REP(6); ++r) { pg8::gemm_phase<pg8::EpiB<3>, pg8::StaticOrder, true, true, true>(lds, g, S, E, (const float*)(ws + WS_RAT), nullptr); RSYNC(6, r); } } SEAM(6);
    if (IN(7)) { for (int r = 0; r < REP(7); ++r) { r3_rows(a, gw, NGW, lane); RSYNC(7, r); } } SEAM(7);
#pragma unroll
    for (int half = 0; half < 2; ++half) {
        const size_t rofs = (size_t)half * 8192;
        if (IN(8 + 2 * half)) { pg8::Gemm g{(const bf16_t*)(ws + WS_H) + rofs * DM, (const bf16_t*)(ws + WS_WFF1), 8192, DFF, DM}; pg8::StaticOrder S; S.init(8192, DFF, G, B);
            pg8::EpiB<1> E{(bf16_t*)(ws + WS_HID), DFF, nullptr, nullptr, 0, nullptr, nullptr};
            for (int r = 0; r < REP(8); ++r) { pg8::gemm_phase<pg8::EpiB<1>, pg8::StaticOrder, true, true>(lds, g, S, E); RSYNC(8, r); } } SEAM(8 + 2 * half);
        if (IN(9 + 2 * half)) { pg8::Gemm g{(const bf16_t*)(ws + WS_HID), (const bf16_t*)(ws + WS_WFF2), 8192, DM, DFF}; pg8::StaticOrder S; S.init(8192, DM, G, B);
            pg8::EpiB<0> E{(bf16_t*)(ws + WS_F) + rofs * DM, DM, nullptr, nullptr, 0, nullptr, nullptr};
            for (int r = 0; r < REP(9); ++r) { pg8::gemm_phase<pg8::EpiB<0>, pg8::StaticOrder, false, true>(lds, g, S, E); RSYNC(9, r); } } SEAM(9 + 2 * half);
    }
    if (IN(12)) { r4_rows(a, gw, NGW, lane); }
    if (a.ph_hi < 0) cg::this_grid().sync();
#undef IN
#undef SEAM
}

extern "C" void kernel_launch(void* const* d_in, const int* in_sizes, int n_in, void* d_out, int out_size, void* d_ws, size_t ws_size, hipStream_t stream) {
    static int grid = 0;
    if (grid == 0) {
        if (n_in != 30 || ws_size < WS_END) { fprintf(stderr, "kernel_launch: unexpected n_in %d / ws_size %zu (need %zu)\n", n_in, ws_size, (size_t)WS_END); grid = -1; return; }
        int dev = 0, cus = 0, per_cu = 0;
        hipGetDevice(&dev); hipDeviceGetAttribute(&cus, hipDeviceAttributeMultiprocessorCount, dev);
        hipFuncSetAttribute((const void*)fwd_kernel, hipFuncAttributeMaxDynamicSharedMemorySize, LDS_BYTES);
        hipOccupancyMaxActiveBlocksPerMultiprocessor(&per_cu, (const void*)fwd_kernel, NTHR, LDS_BYTES);
        if (per_cu < 1) per_cu = 1;
        (void)hipGetLastError();
        grid = cus * per_cu;
        if (grid > 256) grid = 256;
    }
    if (grid < 0) return;
    (void)hipMemsetAsync((unsigned char*)d_ws + WS_CTL, 0, CTL_BYTES, stream);
    Args a{};
    for (int i = 0; i < 30; ++i) a.in[i] = (const float*)d_in[i];
    a.out = (float*)d_out; a.ws = (unsigned char*)d_ws;
#if MK_MULTI
    for (int p = 0; p < NPH; ++p) { a.ph_lo = p; a.ph_hi = p + 1; hipLaunchKernelGGL(fwd_kernel, dim3(grid), dim3(NTHR), LDS_BYTES, stream, a); }
#else
    a.ph_lo = 0; a.ph_hi = NPH;
    void* args[] = {&a};
    hipError_t e = hipLaunchCooperativeKernel((const void*)fwd_kernel, dim3(grid), dim3(NTHR), args, LDS_BYTES, stream);
    if (e != hipSuccess) fprintf(stderr, "cooperative launch failed: %s (grid %d)\n", hipGetErrorString(e), grid);
#endif
}
```
